# Optimizing an MI355X kernel written in HIP

```python
import jax
import jax.numpy as jnp
from jax import lax
import numpy as np


D_MODEL = 2048
BATCH = 2
SEQ = 4096
DEPTH = 1

CHUNK = 64
NORM_EPS = 1e-6

RET_HEADS = 4
RET_DK = 256
RET_DV = 256
RET_QK = RET_HEADS * RET_DK
RET_WIDTH = RET_HEADS * RET_DV
ROPE_BASE = 10000.0

RWKV_HEAD = 64
RWKV_WIDTH = D_MODEL // 2
RWKV_HEADS = RWKV_WIDTH // RWKV_HEAD
DECAY_LORA = 64
AAA_LORA = 64
GATE_LORA = 128
RWKV_COLS = 3 * RWKV_WIDTH + DECAY_LORA + AAA_LORA + GATE_LORA
RWKV_GN_EPS = 64e-5

IN_COLS = 2 * RET_QK + 2 * RET_WIDTH + RWKV_COLS + 2 * D_MODEL

PEER_HEADS = 8
PEER_NKEYS = 128
PEER_NEXPERTS = PEER_NKEYS * PEER_NKEYS
PEER_DQ = 256
PEER_TOPK = 16
PEER_BLOCK = 128

kernel_name = 'hybrid_retention_rwkv7_peer_block'


def _split(z, sizes):
    idx = [int(s) for s in np.cumsum(sizes)[:-1]]
    return jnp.split(z, idx, axis=-1)


def rms_norm(x, w):
    xf = x.astype(jnp.float32)
    y = xf * lax.rsqrt(jnp.mean(xf * xf, axis=-1, keepdims=True) + NORM_EPS)
    return (y * w.astype(jnp.float32)).astype(x.dtype)


def head_norm(z, w, b, eps):
    h, d = z.shape[-2], z.shape[-1]
    zf = z.astype(jnp.float32)
    mu = jnp.mean(zf, axis=-1, keepdims=True)
    var = jnp.mean(jnp.square(zf - mu), axis=-1, keepdims=True)
    y = (zf - mu) * lax.rsqrt(var + eps)
    y = y * w.reshape(h, d).astype(jnp.float32) + b.reshape(h, d).astype(jnp.float32)
    return y.astype(z.dtype)


def rotary(z, pos):
    d = z.shape[-1]
    half = d // 2
    inv_freq = ROPE_BASE ** (-jnp.arange(half, dtype=jnp.float32) * 2.0 / d)
    ang = pos.astype(jnp.float32)[:, None] * inv_freq[None, :]
    cos = jnp.cos(ang)[None, :, None, :]
    sin = jnp.sin(ang)[None, :, None, :]
    zf = z.astype(jnp.float32)
    z1, z2 = zf[..., :half], zf[..., half:]
    return jnp.concatenate([z1 * cos - z2 * sin, z2 * cos + z1 * sin], axis=-1).astype(z.dtype)


def retention_chunkwise(q, k, v):
    b, t, h, dk = q.shape
    nc = t // CHUNK
    log_g = jnp.log(1.0 - jnp.exp2(-5.0 - jnp.arange(h, dtype=jnp.float32)))
    n = jnp.arange(CHUNK, dtype=jnp.float32)
    d_intra = jnp.exp(log_g[:, None, None] * jnp.abs(n[:, None] - n[None, :]))
    q_decay = jnp.exp(log_g[:, None] * (n[None, :] + 1.0))
    k_decay = jnp.exp(log_g[:, None] * (CHUNK - 1.0 - n[None, :]))
    chunk_decay = jnp.exp(log_g * CHUNK)

    def to_chunks(z):
        return z.reshape(b, nc, CHUNK, h, z.shape[-1]).transpose(0, 3, 1, 2, 4)

    qc, kc, vc = to_chunks(q), to_chunks(k), to_chunks(v)
    scores = jnp.einsum('bhcnd,bhcmd->bhcnm', qc, kc) * d_intra[None, :, None].astype(q.dtype)
    o_intra = jnp.einsum('bhcnm,bhcme->bhcne', scores, vc)
    kv = jnp.einsum('bhcmd,bhcme->bhcde', kc * k_decay[None, :, None, :, None].astype(k.dtype), vc)
    kv = jnp.moveaxis(kv, 2, 0).astype(jnp.float32)

    def step(s, kv_c):
        return s * chunk_decay[None, :, None, None] + kv_c, s

    s0 = jnp.zeros((b, h, dk, vc.shape[-1]), jnp.float32)
    _, s_prev = lax.scan(step, s0, kv)
    o_inter = jnp.einsum('bhcnd,cbhde->bhcne', qc * q_decay[None, :, None, :, None].astype(q.dtype),
                         s_prev.astype(q.dtype))
    o = o_intra + o_inter
    return o.transpose(0, 2, 3, 1, 4).reshape(b, t, h, vc.shape[-1])


def rwkv7_time_mix(z, mix, w0, w_up, a0, a_up, g_up, k_k, k_a, r_k, ln_w, ln_b):
    b, t, _ = z.shape
    z_prev = jnp.pad(z, ((0, 0), (1, 0), (0, 0)))[:, :-1]
    z = z + (z_prev - z) * mix
    r, k, v, xw, xa, xg = _split(z, [RWKV_WIDTH, RWKV_WIDTH, RWKV_WIDTH, DECAY_LORA, AAA_LORA, GATE_LORA])
    w = -jax.nn.softplus(-(w0 + jnp.tanh(xw) @ w_up)) - 0.5
    a = jax.nn.sigmoid(a0 + xa @ a_up)
    g = jax.nn.sigmoid(xg) @ g_up

    def heads(u):
        return u.reshape(b, t, RWKV_HEADS, RWKV_HEAD)

    kk = heads(k * k_k)
    kkf = kk.astype(jnp.float32)
    kk = (kkf / jnp.maximum(jnp.sqrt(jnp.sum(kkf * kkf, axis=-1, keepdims=True)), 1e-12)).astype(k.dtype)
    k = k * (1.0 + (a - 1.0) * k_a)
    r, k, v, a = heads(r), heads(k), heads(v), heads(a)
    decay = jnp.exp(-jnp.exp(heads(w).astype(jnp.float32)))

    def step(s, inp):
        r_t, w_t, k_t, v_t, kk_t, a_t = inp
        sa = jnp.einsum('bhij,bhj->bhi', s, -kk_t)
        s = s * w_t[:, :, None, :] + sa[..., None] * (kk_t * a_t)[:, :, None, :] + v_t[..., None] * k_t[:, :, None, :]
        return s, jnp.einsum('bhij,bhj->bhi', s, r_t)

    xs = tuple(jnp.moveaxis(u, 1, 0).astype(jnp.float32) for u in (r, decay, k, v, kk, a))
    s0 = jnp.zeros((b, RWKV_HEADS, RWKV_HEAD, RWKV_HEAD), jnp.float32)
    _, y = lax.scan(step, s0, xs)
    y = jnp.moveaxis(y, 0, 1).astype(z.dtype)
    y = head_norm(y, ln_w, ln_b, RWKV_GN_EPS)
    y = y + jnp.sum(r * k * r_k, axis=-1, keepdims=True) * v
    return y.reshape(b, t, RWKV_WIDTH) * g


def peer(u, w_q, keys_1, keys_2, expert_u, expert_v):
    b, t, d = u.shape
    tok = u.reshape(b * t, d)
    ntok = b * t
    q = (tok @ w_q).reshape(ntok, PEER_HEADS, 2, PEER_DQ // 2)
    s1 = jnp.einsum('nhd,kd->nhk', q[:, :, 0], keys_1).astype(jnp.float32)
    s2 = jnp.einsum('nhd,kd->nhk', q[:, :, 1], keys_2).astype(jnp.float32)
    v1, i1 = lax.top_k(s1, PEER_TOPK)
    v2, i2 = lax.top_k(s2, PEER_TOPK)
    cand = (v1[..., :, None] + v2[..., None, :]).reshape(ntok, PEER_HEADS, PEER_TOPK * PEER_TOPK)
    top, idx = lax.top_k(cand, PEER_TOPK)
    e1 = jnp.take_along_axis(i1, idx // PEER_TOPK, axis=-1)
    e2 = jnp.take_along_axis(i2, idx % PEER_TOPK, axis=-1)
    experts = e1 * PEER_NKEYS + e2
    gates = jax.nn.softmax(top, axis=-1).astype(u.dtype)
    nb = ntok // PEER_BLOCK

    def block(args):
        xb, eb, gb = args
        ue = jnp.take(expert_u, eb, axis=0)
        act = jax.nn.gelu(jnp.einsum('nhkd,nd->nhk', ue, xb), approximate=False) * gb
        return jnp.einsum('nhk,nhkd->nd', act, jnp.take(expert_v, eb, axis=0))

    out = lax.map(block, (tok.reshape(nb, PEER_BLOCK, d),
                          experts.reshape(nb, PEER_BLOCK, PEER_HEADS, PEER_TOPK),
                          gates.reshape(nb, PEER_BLOCK, PEER_HEADS, PEER_TOPK)))
    return out.reshape(b, t, d)


def setup_inputs(seed: int = 0) -> dict:
    key = jax.random.key(seed)
    ks = jax.random.split(key, 32)
    f32 = jnp.float32
    L = DEPTH

    def nrm(k, shape, scale):
        return jax.random.normal(k, shape, f32) * scale

    return {
        'x': nrm(ks[0], (BATCH, SEQ, D_MODEL), 1.0),
        'norm1_w': 1.0 + nrm(ks[1], (L, D_MODEL), 0.02),
        'w_in': nrm(ks[2], (L, D_MODEL, IN_COLS), D_MODEL ** -0.5),
        'ret_gn_w': 1.0 + nrm(ks[3], (L, RET_WIDTH), 0.02),
        'ret_gn_b': nrm(ks[4], (L, RET_WIDTH), 0.02),
        'rwkv_mix': jax.random.uniform(ks[5], (L, RWKV_COLS), f32),
        'rwkv_w0': jax.random.uniform(ks[6], (L, RWKV_WIDTH), f32, -6.0, -1.0),
        'rwkv_w_up': nrm(ks[7], (L, DECAY_LORA, RWKV_WIDTH), 0.5 * DECAY_LORA ** -0.5),
        'rwkv_a0': nrm(ks[8], (L, RWKV_WIDTH), 0.1),
        'rwkv_a_up': nrm(ks[9], (L, AAA_LORA, RWKV_WIDTH), 0.5 * AAA_LORA ** -0.5),
        'rwkv_g_up': nrm(ks[10], (L, GATE_LORA, RWKV_WIDTH), GATE_LORA ** -0.5),
        'rwkv_k_k': 0.85 + nrm(ks[11], (L, RWKV_WIDTH), 0.02),
        'rwkv_k_a': 1.0 + nrm(ks[12], (L, RWKV_WIDTH), 0.02),
        'rwkv_r_k': nrm(ks[13], (L, RWKV_HEADS, RWKV_HEAD), 0.1),
        'rwkv_ln_w': 1.0 + nrm(ks[14], (L, RWKV_WIDTH), 0.02),
        'rwkv_ln_b': nrm(ks[15], (L, RWKV_WIDTH), 0.02),
        'w_ret_branch': nrm(ks[16], (L, RET_WIDTH, D_MODEL), RET_WIDTH ** -0.5),
        'w_rwkv_branch': nrm(ks[17], (L, RWKV_WIDTH, D_MODEL), RWKV_WIDTH ** -0.5),
        'w_out': nrm(ks[18], (L, D_MODEL, D_MODEL), D_MODEL ** -0.5),
        'norm2_w': 1.0 + nrm(ks[19], (L, D_MODEL), 0.02),
        'peer_w_q': nrm(ks[20], (L, D_MODEL, PEER_HEADS * PEER_DQ), D_MODEL ** -0.5),
        'peer_keys_1': nrm(ks[21], (L, PEER_NKEYS, PEER_DQ // 2), (PEER_DQ // 2) ** -0.5),
        'peer_keys_2': nrm(ks[22], (L, PEER_NKEYS, PEER_DQ // 2), (PEER_DQ // 2) ** -0.5),
        'peer_u': nrm(ks[23], (L, PEER_NEXPERTS, D_MODEL), D_MODEL ** -0.5),
        'peer_v': nrm(ks[24], (L, PEER_NEXPERTS, D_MODEL), 0.5),
        'final_norm_w': 1.0 + nrm(ks[25], (D_MODEL,), 0.02),
    }


def reference(x, norm1_w, w_in, ret_gn_w, ret_gn_b, rwkv_mix, rwkv_w0, rwkv_w_up, rwkv_a0,
              rwkv_a_up, rwkv_g_up, rwkv_k_k, rwkv_k_a, rwkv_r_k, rwkv_ln_w, rwkv_ln_b,
              w_ret_branch, w_rwkv_branch, w_out, norm2_w, peer_w_q, peer_keys_1, peer_keys_2,
              peer_u, peer_v, final_norm_w):
    b, t, _ = x.shape
    pos = jnp.arange(t, dtype=jnp.int32)
    for layer in range(DEPTH):
        h = rms_norm(x, norm1_w[layer])
        z = h @ w_in[layer]
        q, k, v, g_ret_out, z_rwkv, gate_ret, gate_rwkv = _split(
            z, [RET_QK, RET_QK, RET_WIDTH, RET_WIDTH, RWKV_COLS, D_MODEL, D_MODEL])
        q = rotary(q.reshape(b, t, RET_HEADS, RET_DK), pos)
        k = rotary(k.reshape(b, t, RET_HEADS, RET_DK), pos) * (RET_DK ** -0.5)
        o_ret = retention_chunkwise(q, k, v.reshape(b, t, RET_HEADS, RET_DV))
        o_ret = head_norm(o_ret, ret_gn_w[layer], ret_gn_b[layer], NORM_EPS).reshape(b, t, RET_WIDTH)
        o_ret = o_ret * jax.nn.silu(g_ret_out)
        o_rwkv = rwkv7_time_mix(z_rwkv, rwkv_mix[layer], rwkv_w0[layer], rwkv_w_up[layer], rwkv_a0[layer],
                                rwkv_a_up[layer], rwkv_g_up[layer], rwkv_k_k[layer], rwkv_k_a[layer],
                                rwkv_r_k[layer], rwkv_ln_w[layer], rwkv_ln_b[layer])
        merged = (jax.nn.sigmoid(gate_ret) * (o_ret @ w_ret_branch[layer])
                  + jax.nn.sigmoid(gate_rwkv) * (o_rwkv @ w_rwkv_branch[layer]))
        x = x + merged @ w_out[layer]
        h2 = rms_norm(x, norm2_w[layer])
        x = x + peer(h2, peer_w_q[layer], peer_keys_1[layer], peer_keys_2[layer], peer_u[layer], peer_v[layer])
    return rms_norm(x, final_norm_w)
```

```cpp
#include <hip/hip_runtime.h>
#include <hip/hip_cooperative_groups.h>
#include <cstdio>
#include <cstdint>
namespace pg8 {
#define PG8_LAS __attribute__((address_space(3)))
typedef unsigned short bf16_t;
typedef short bf16x8 __attribute__((ext_vector_type(8)));
typedef float f32x4 __attribute__((ext_vector_type(4)));
typedef unsigned u32x4 __attribute__((ext_vector_type(4)));
typedef int i32x4 __attribute__((ext_vector_type(4)));
constexpr int BM = 256, BK = 64, HALF = 128, HTB = HALF * BK * 2  , STAGE_BYTES = 8 * HTB, NXCD = 8, WGM = 8;

__host__ __device__ __forceinline__ int lds_byte(int r, int c) { const int st = (r >> 4) * 2 + (c >> 5), rr = r & 15, cc = c & 31, ob = rr * 64 + cc * 2; return st * 1024 + (ob ^ (((ob >> 9) & 1) << 5)); }
__host__ __device__ __forceinline__ void stage_rc(int b, int& R, int& C) { const int st = b / 1024, sb = b % 1024, swz = sb ^ (((sb >> 9) & 1) << 5); R = (st >> 1) * 16 + swz / 64; C = (st & 1) * 32 + (swz % 64) / 2; }
__host__ __device__ __forceinline__ int perm32(int rho) { const int n = rho >> 4, i = rho & 15; return 8 * (i >> 2) + 4 * n + (i & 3); }

struct Unit { int pm, pn; };
struct Gemm { const bf16_t* A; const bf16_t* Bt; int M, N, K; };

struct StaticOrder {
    int nM, nN, nwg, G, c;
    __host__ __device__ __forceinline__ void init(int M, int N, int G_, int c_) { nM = M / BM; nN = N / BM; nwg = nM * nN; G = G_; c = c_; }
    __host__ __device__ __forceinline__ bool next(int i, Unit& u) const {
        const long L = (long)i * G + c; if (L >= nwg) return false;
        int wgid = (int)L; { const int q = nwg / NXCD, r = nwg % NXCD, xcd = wgid % NXCD, off = wgid / NXCD; wgid = (xcd < r ? xcd * (q + 1) : r * (q + 1) + (xcd - r) * q) + off; }
        const int nig = WGM * nN, gid = wgid / nig, fm = gid * WGM, gsz = (nM - fm) < WGM ? (nM - fm) : WGM;
        u.pm = fm + ((wgid % nig) % gsz); u.pn = (wgid % nig) / gsz; return true;
    }
    __device__ __forceinline__ void a_ready(const Unit&) const {}
    __device__ __forceinline__ void done(const Unit&) const {}
};

struct SubOrder {
    int nM, nNb, pn0, NGb, c;
    __device__ __forceinline__ bool next(int i, Unit& u) const { const int L = i * NGb + c; if (L >= nM * nNb) return false; u.pm = L % nM; u.pn = pn0 + L / nM; return true; }
    __device__ __forceinline__ void a_ready(const Unit&) const {}
    __device__ __forceinline__ void done(const Unit&) const {}
};

typedef float f32x2c_t __attribute__((ext_vector_type(2))); typedef __bf16 bf16x2c_t __attribute__((ext_vector_type(2)));
__device__ __forceinline__ unsigned cvt_pk_bf16(float lo, float hi) { f32x2c_t v = {lo, hi}; bf16x2c_t b = __builtin_convertvector(v, bf16x2c_t); return __builtin_bit_cast(unsigned, b); }
typedef float f32x2 __attribute__((ext_vector_type(2)));
__device__ __forceinline__ f32x2 gelu_pk(f32x2 v) {
    const f32x2 av = __builtin_elementwise_abs(v), d = av * 0.2316418882f + 1.0f;
    f32x2 t; t.x = __builtin_amdgcn_rcpf(d.x); t.y = __builtin_amdgcn_rcpf(d.y);
    f32x2 q = t * 0.5307027145f + (-0.7265760135f); q = q * t + 0.7107068705f; q = q * t + (-0.142248368f); q = q * t + 0.127414796f; q = q * t;
    const f32x2 s = (v * v) * (-0.72134752044f);
    f32x2 e; e.x = __builtin_amdgcn_exp2f(s.x); e.y = __builtin_amdgcn_exp2f(s.y);
    const f32x2 m = v * (q * e), r = v - m;
    f32x2 o; o.x = v.x < 0.f ? m.x : r.x; o.y = v.y < 0.f ? m.y : r.y; return o;
}


__device__ __forceinline__ float fast_sigmoid(float v) { return __builtin_amdgcn_rcpf(1.0f + __expf(-v)); }
__device__ __forceinline__ u32x4 pack8(const f32x4 v0, const f32x4 v1) { u32x4 w; w.x = cvt_pk_bf16(v0[0], v0[1]); w.y = cvt_pk_bf16(v0[2], v0[3]); w.z = cvt_pk_bf16(v1[0], v1[1]); w.w = cvt_pk_bf16(v1[2], v1[3]); return w; }
__device__ __forceinline__ void unpack8(const u32x4 w, f32x4& v0, f32x4& v1) {
    v0[0] = __uint_as_float(w.x << 16); v0[1] = __uint_as_float(w.x & 0xffff0000u); v0[2] = __uint_as_float(w.y << 16); v0[3] = __uint_as_float(w.y & 0xffff0000u);
    v1[0] = __uint_as_float(w.z << 16); v1[1] = __uint_as_float(w.z & 0xffff0000u); v1[2] = __uint_as_float(w.w << 16); v1[3] = __uint_as_float(w.w & 0xffff0000u); }

struct EpiZ {
    static constexpr bool PERM = true, AFTER_DRAIN = false;
    bf16_t *Qb, *Kb, *Vr, *Gb, *Zr, *SG; const float* rcos; const float* rsin; const float* SA; const unsigned* SBM;
    static __device__ __forceinline__ f32x4 deq(const f32x4 a, const float sa, const f32x4 sb) { const i32x4 i = __builtin_bit_cast(i32x4, a); return (f32x4){(float)i[0] * sa * sb[0], (float)i[1] * sa * sb[1], (float)i[2] * sa * sb[2], (float)i[3] * sa * sb[3]}; }
    template <int ACT> __device__ __forceinline__ void plain(const f32x4 (&acc)[2][2][4][2], bf16_t* O, int ldc, int row0, int cl, const f32x4 (&sb)[2][2]) const {
#pragma unroll
        for (int ai = 0; ai < 2; ++ai)
#pragma unroll
            for (int m = 0; m < 4; ++m) { bf16_t* rowp = O + (size_t)(row0 + ai * HALF + m * 16) * ldc + cl; const float sa = SA[row0 + ai * HALF + m * 16];
#pragma unroll
                for (int bj = 0; bj < 2; ++bj) { f32x4 v0 = deq(acc[ai][bj][m][0], sa, sb[bj][0]), v1 = deq(acc[ai][bj][m][1], sa, sb[bj][1]);
                    if (ACT == 1) {
#pragma unroll
                        for (int j = 0; j < 4; ++j) { v0[j] = v0[j] * fast_sigmoid(v0[j]); v1[j] = v1[j] * fast_sigmoid(v1[j]); } }
                    if (ACT == 2) {
#pragma unroll
                        for (int j = 0; j < 4; ++j) { v0[j] = fast_sigmoid(v0[j]); v1[j] = fast_sigmoid(v1[j]); } }
                    *(u32x4*)(rowp + bj * HALF) = pack8(v0, v1); } }
    }
    __device__ __forceinline__ void operator()(const f32x4 (&acc)[2][2][4][2], const Unit& u, int wr, int wc, int fr, int fq) const {
        const int pn = u.pn, row0 = u.pm * BM + wr * 64 + fr, cl = wc * 32 + 8 * fq;
        f32x4 sb[2][2];
#pragma unroll
        for (int bj = 0; bj < 2; ++bj)
#pragma unroll
            for (int hh = 0; hh < 2; ++hh) { const u32x4 t = *(const u32x4*)(SBM + pn * 256 + cl + bj * HALF + 4 * hh);
                sb[bj][hh] = (f32x4){__uint_as_float(t.x), __uint_as_float(t.y), __uint_as_float(t.z), __uint_as_float(t.w)} * (1.0f / 127.0f); }
        if (pn < 8) {
            bf16_t* O = (pn < 4 ? Qb : Kb) + (pn & 3) * 256; const float sc = pn < 4 ? 1.0f : 0.0625f;
#pragma unroll
            for (int ai = 0; ai < 2; ++ai)
#pragma unroll
                for (int m = 0; m < 4; ++m) { const int row = row0 + ai * HALF + m * 16, pos = row & 4095;
                    const float* cp = rcos + pos * 128 + cl; const float* sp = rsin + pos * 128 + cl;
                    const f32x4 c0 = *(const f32x4*)cp, c1 = *(const f32x4*)(cp + 4), s0 = *(const f32x4*)sp, s1 = *(const f32x4*)(sp + 4);
                    const float sa = SA[row];
                    const f32x4 z1a = deq(acc[ai][0][m][0], sa, sb[0][0]), z1b = deq(acc[ai][0][m][1], sa, sb[0][1]), z2a = deq(acc[ai][1][m][0], sa, sb[1][0]), z2b = deq(acc[ai][1][m][1], sa, sb[1][1]);
                    const f32x4 o1a = (z1a * c0 - z2a * s0) * sc, o1b = (z1b * c1 - z2b * s1) * sc, o2a = (z2a * c0 + z1a * s0) * sc, o2b = (z2b * c1 + z1b * s1) * sc;
                    bf16_t* rowp = O + (size_t)row * 1024 + cl;
                    *(u32x4*)(rowp) = pack8(o1a, o1b); *(u32x4*)(rowp + HALF) = pack8(o2a, o2b); }
        } else if (pn < 12) plain<0>(acc, Vr + (pn - 8) * 256, 1024, row0, cl, sb);
        else if (pn < 16) plain<1>(acc, Gb + (pn - 12) * 256, 1024, row0, cl, sb);
        else if (pn < 29) plain<0>(acc, Zr + (pn - 16) * 256, 3328, row0, cl, sb);
        else plain<2>(acc, SG + (pn - 29) * 256, 4096, row0, cl, sb);
    }
};
struct EpiLora {
    static constexpr bool PERM = true, AFTER_DRAIN = false;
    float* DEC; bf16_t* Ab; bf16_t* Gg; const float* w0; const float* a0;
    __device__ __forceinline__ void operator()(const f32x4 (&acc)[2][2][4][2], const Unit& u, int wr, int wc, int fr, int fq) const {
        const int pn = u.pn, row0 = u.pm * BM + wr * 64 + fr, cl = wc * 32 + 8 * fq;
        if (pn < 4) {
            const int cb = pn * 256 + cl;
#pragma unroll
            for (int ai = 0; ai < 2; ++ai)
#pragma unroll
                for (int m = 0; m < 4; ++m) {
#pragma unroll
                    for (int bj = 0; bj < 2; ++bj) { const f32x4 b0 = *(const f32x4*)(w0 + cb + bj * HALF), b1 = *(const f32x4*)(w0 + cb + bj * HALF + 4);
                        f32x4 v0 = acc[ai][bj][m][0] + b0, v1 = acc[ai][bj][m][1] + b1;
#pragma unroll
                        for (int j = 0; j < 4; ++j) {
                            { const float y = -v0[j]; const float sp = fmaxf(y, 0.f) + __logf(1.0f + __expf(-fabsf(y))); v0[j] = __expf(-__expf(-sp - 0.5f)); }
                            { const float y = -v1[j]; const float sp = fmaxf(y, 0.f) + __logf(1.0f + __expf(-fabsf(y))); v1[j] = __expf(-__expf(-sp - 0.5f)); } }
                        float* rowp = DEC + (size_t)(row0 + ai * HALF + m * 16) * 1024 + cb + bj * HALF;
                        *(f32x4*)rowp = v0; *(f32x4*)(rowp + 4) = v1; asm volatile("" ::: "memory"); } }
        } else if (pn < 8) {
            const int cb = (pn - 4) * 256 + cl;
#pragma unroll
            for (int bj = 0; bj < 2; ++bj) { const f32x4 b0 = *(const f32x4*)(a0 + cb + bj * HALF), b1 = *(const f32x4*)(a0 + cb + bj * HALF + 4);
#pragma unroll
                for (int ai = 0; ai < 2; ++ai)
#pragma unroll
                    for (int m = 0; m < 4; ++m) { f32x4 v0 = acc[ai][bj][m][0] + b0, v1 = acc[ai][bj][m][1] + b1;
#pragma unroll
                        for (int j = 0; j < 4; ++j) { v0[j] = fast_sigmoid(v0[j]); v1[j] = fast_sigmoid(v1[j]); }
                        *(u32x4*)(Ab + (size_t)(row0 + ai * HALF + m * 16) * 1024 + cb + bj * HALF) = pack8(v0, v1); asm volatile("" ::: "memory"); } }
        } else {
            const int cb = (pn - 8) * 256 + cl;
#pragma unroll
            for (int ai = 0; ai < 2; ++ai)
#pragma unroll
                for (int m = 0; m < 4; ++m)
#pragma unroll
                    for (int bj = 0; bj < 2; ++bj) *(u32x4*)(Gg + (size_t)(row0 + ai * HALF + m * 16) * 1024 + cb + bj * HALF) = pack8(acc[ai][bj][m][0], acc[ai][bj][m][1]);
        }
    }
};
template <int MODE> struct EpiGen {
    static constexpr bool PERM = true, AFTER_DRAIN = false;
    const bf16_t* SG; int goff; float* F; bf16_t* O; const float* xres; int ldo; const float* SA = nullptr; const unsigned* SBM = nullptr;
    __device__ __forceinline__ void operator()(const f32x4 (&acc)[2][2][4][2], const Unit& u, int wr, int wc, int fr, int fq) const {
        const int row0 = u.pm * BM + wr * 64 + fr, col0 = u.pn * BM + wc * 32 + 8 * fq;

#pragma unroll
        for (int ai = 0; ai < 2; ++ai)
#pragma unroll
            for (int m = 0; m < 4; ++m) { const size_t row = (size_t)(row0 + ai * HALF + m * 16);
#pragma unroll
                for (int bj = 0; bj < 2; ++bj) { const int col = col0 + bj * HALF; f32x4 v0 = acc[ai][bj][m][0], v1 = acc[ai][bj][m][1];
                    if (MODE == 0 || MODE == 1) { const float sa = SA[row] * (1.0f / 127.0f); const u32x4 t0 = *(const u32x4*)(SBM + col), t1 = *(const u32x4*)(SBM + col + 4);
                        v0 = EpiZ::deq(v0, sa, (f32x4){__uint_as_float(t0.x), __uint_as_float(t0.y), __uint_as_float(t0.z), __uint_as_float(t0.w)}); v1 = EpiZ::deq(v1, sa, (f32x4){__uint_as_float(t1.x), __uint_as_float(t1.y), __uint_as_float(t1.z), __uint_as_float(t1.w)}); }
                    if (MODE == 0 || MODE == 1) { f32x4 g0, g1; unpack8(*(const u32x4*)(SG + row * 4096 + goff + col), g0, g1); v0 = v0 * g0; v1 = v1 * g1; }
                    if (MODE == 0) { *(u32x4*)((bf16_t*)F + row * 2048 + col) = pack8(v0, v1); }
                    if (MODE == 1) { f32x4 p0, p1; unpack8(*(const u32x4*)((const bf16_t*)F + row * 2048 + col), p0, p1); v0 = v0 + p0; v1 = v1 + p1; *(u32x4*)(O + row * 2048 + col) = pack8(v0, v1); }
                    if (MODE == 2) { const float* p = xres + row * 2048 + col; v0 = v0 + *(const f32x4*)p; v1 = v1 + *(const f32x4*)(p + 4); float* q = F + row * 2048 + col; *(f32x4*)q = v0; *(f32x4*)(q + 4) = v1; }
                    if (MODE == 3) { *(u32x4*)(O + row * (size_t)ldo + col) = pack8(v0, v1); }
                    if (MODE == 4) { float* q = F + row * (size_t)ldo + col; *(f32x4*)q = v0; *(f32x4*)(q + 4) = v1; }
                    if (MODE == 5) { *(u32x4*)(O + ((size_t)(col >> 11) * 256 + row) * 2048 + (col & 2047)) = pack8(v0, v1); } }
                asm volatile("" ::: "memory"); }
    }
};
struct EpiX1 {
    static constexpr bool PERM = true, AFTER_DRAIN = false;
    const float* xres; float* X1; bf16_t* XW; const float* nw; float* PART;
    __device__ __forceinline__ void operator()(const f32x4 (&acc)[2][2][4][2], const Unit& u, int wr, int wc, int fr, int fq) const {
        const int row0 = u.pm * BM + wr * 64 + fr, col0 = u.pn * BM + wc * 32 + 8 * fq;
#pragma unroll
        for (int ai = 0; ai < 2; ++ai)
#pragma unroll
            for (int m = 0; m < 4; ++m) { const size_t row = (size_t)(row0 + ai * HALF + m * 16); float ss = 0.f;
#pragma unroll
                for (int bj = 0; bj < 2; ++bj) { const int col = col0 + bj * HALF; const float* p = xres + row * 2048 + col;
                    const f32x4 v0 = acc[ai][bj][m][0] + *(const f32x4*)p, v1 = acc[ai][bj][m][1] + *(const f32x4*)(p + 4);
                    float* q = X1 + row * 2048 + col; *(f32x4*)q = v0; *(f32x4*)(q + 4) = v1;
                    ss += (v0[0] * v0[0] + v0[1] * v0[1]) + (v0[2] * v0[2] + v0[3] * v0[3]) + (v1[0] * v1[0] + v1[1] * v1[1]) + (v1[2] * v1[2] + v1[3] * v1[3]);
                    const f32x4 w0 = *(const f32x4*)(nw + col), w1 = *(const f32x4*)(nw + col + 4);
                    *(u32x4*)(XW + row * 2048 + col) = pack8(v0 * w0, v1 * w1); }
                ss += __shfl_xor(ss, 16); ss += __shfl_xor(ss, 32);
                if (fq == 0) PART[row * 32 + u.pn * 4 + wc] = ss;
                asm volatile("" ::: "memory"); }
    }
};
struct EpiScore {
    static constexpr bool PERM = true, AFTER_DRAIN = false;
    float* C; const PG8_LAS float* rstd;
    __device__ __forceinline__ void operator()(const f32x4 (&acc)[2][2][4][2], const Unit& u, int wr, int wc, int fr, int fq) const {
        const int rl0 = wr * 64 + fr, col0 = u.pn * BM + wc * 32 + 8 * fq;
#pragma unroll
        for (int ai = 0; ai < 2; ++ai)
#pragma unroll
            for (int m = 0; m < 4; ++m) { const int rl = rl0 + ai * HALF + m * 16; const float r = rstd[rl]; const size_t row = (size_t)(u.pm * BM + rl);
#pragma unroll
                for (int bj = 0; bj < 2; ++bj) { float* q = C + row * 2048 + col0 + bj * HALF; *(f32x4*)q = acc[ai][bj][m][0] * r; *(f32x4*)(q + 4) = acc[ai][bj][m][1] * r; }
                asm volatile("" ::: "memory"); }
    }
};
template <class Epi, class Sched, bool ALIGN_EPI = false, bool SP2 = false, bool I8 = false>
__device__ __forceinline__ void gemm_phase(PG8_LAS unsigned char* lds, const Gemm g, const Sched& S, const Epi& E) {
    const int tid = threadIdx.x, wid = __builtin_amdgcn_readfirstlane(tid >> 6), lane = tid & 63, wr = wid >> 2, wc = wid & 3, fr = lane & 15, fq = lane >> 4;
    const int K = g.K, nt = K / BK;
    unsigned voffA[2], voffB[2];
#pragma unroll
    for (int i = 0; i < 2; ++i) { int R, C; stage_rc(tid * 16 + i * 8192, R, C); const int Rb = Epi::PERM ? ((R & ~31) + perm32(R & 31)) : R;
        voffA[i] = (unsigned)(R * K + C) * 2u; voffB[i] = (unsigned)(Rb * K + C) * 2u; }
    const size_t kstep = (size_t)(BK * 2);
    const size_t hstep = (size_t)HALF * K * 2;
    const size_t tstep = 2 * hstep;
    const unsigned ldsw = (unsigned)wid * 1024u;
    const int aoff = lds_byte(wr * 64 + fr, fq * 8), boff = lds_byte(wc * 32 + fr, fq * 8);
#define PG8_SA(b, h) (((b) * 2 + (h)) * HTB)
#define PG8_SB(b, h) ((4 + (b) * 2 + (h)) * HTB)
#define PG8_STAGE(bufoff, gbase, voff) do { _Pragma("unroll") for (int _i = 0; _i < 2; ++_i) \
        __builtin_amdgcn_global_load_lds((const unsigned*)((const char*)(gbase) + (voff)[_i]), (PG8_LAS unsigned*)(lds + (bufoff) + ldsw + _i * 8192), 16, 0, 0); } while (0)
#define PG8_LDA(dst, b, h) do { _Pragma("unroll") for (int m = 0; m < 4; ++m) _Pragma("unroll") for (int k = 0; k < 2; ++k) dst[m][k] = *(const PG8_LAS bf16x8*)(lds + PG8_SA(b, h) + aoff + m * 2048 + k * 1024); } while (0)
#define PG8_LDB(dst, b, h) do { _Pragma("unroll") for (int n = 0; n < 2; ++n) _Pragma("unroll") for (int k = 0; k < 2; ++k) dst[n][k] = *(const PG8_LAS bf16x8*)(lds + PG8_SB(b, h) + boff + n * 2048 + k * 1024); } while (0)
#define PG8_MMA(ai, bj, At, Bt) do { __builtin_amdgcn_s_setprio(1); _Pragma("unroll") for (int m = 0; m < 4; ++m) _Pragma("unroll") for (int n = 0; n < 2; ++n) _Pragma("unroll") for (int k = 0; k < 2; ++k) { \
        if (I8) acc[ai][bj][m][n] = __builtin_bit_cast(f32x4, __builtin_amdgcn_mfma_i32_16x16x64_i8(__builtin_bit_cast(i32x4, Bt[n][k]), __builtin_bit_cast(i32x4, At[m][k]), __builtin_bit_cast(i32x4, acc[ai][bj][m][n]), 0, 0, 0)); \
        else acc[ai][bj][m][n] = __builtin_amdgcn_mfma_f32_16x16x32_bf16(Bt[n][k], At[m][k], acc[ai][bj][m][n], 0, 0, 0); } __builtin_amdgcn_s_setprio(0); } while (0)
#define PG8_WAIT_V(n) asm volatile("s_waitcnt vmcnt(" #n ")" ::: "memory")
#define PG8_WAIT_L(n) asm volatile("s_waitcnt lgkmcnt(" #n ")" ::: "memory")
#define PG8_BAR __builtin_amdgcn_s_barrier()
#define PG8_SCHED __builtin_amdgcn_sched_barrier(0)
    Unit cur, nxt; int ui = 0;
    if (!S.next(0, cur)) return;
    f32x4 acc[2][2][4][2];
#pragma unroll
    for (int a = 0; a < 2; ++a)
#pragma unroll
        for (int b = 0; b < 2; ++b)
#pragma unroll
            for (int m = 0; m < 4; ++m)
#pragma unroll
                for (int n = 0; n < 2; ++n) acc[a][b][m][n] = (f32x4){0.f, 0.f, 0.f, 0.f};
    bf16x8 At[4][2], B0[2][2], B1[2][2];
    const char* cA = (const char*)g.A + (size_t)cur.pm * tstep; const char* cB = (const char*)g.Bt + (size_t)cur.pn * tstep;
    S.a_ready(cur);
    if constexpr (SP2) {
        PG8_STAGE(PG8_SB(0, 0), cB, voffB); PG8_STAGE(PG8_SB(0, 1), cB + hstep, voffB); PG8_STAGE(PG8_SA(0, 0), cA, voffA); PG8_STAGE(PG8_SA(0, 1), cA + hstep, voffA);
        if (wr == 1) PG8_BAR;
        PG8_WAIT_V(2); PG8_BAR;
        PG8_STAGE(PG8_SB(1, 0), cB + kstep, voffB); PG8_STAGE(PG8_SA(1, 0), cA + kstep, voffA); PG8_STAGE(PG8_SB(1, 1), cB + hstep + kstep, voffB);
        PG8_WAIT_V(6); PG8_BAR;
    } else {
        PG8_STAGE(PG8_SB(0, 0), cB, voffB); PG8_STAGE(PG8_SA(0, 0), cA, voffA); PG8_STAGE(PG8_SB(0, 1), cB + hstep, voffB); PG8_STAGE(PG8_SA(0, 1), cA + hstep, voffA);
        if (wr == 1) PG8_BAR;
        PG8_WAIT_V(4); PG8_BAR;
        PG8_STAGE(PG8_SB(1, 0), cB + kstep, voffB); PG8_STAGE(PG8_SA(1, 0), cA + kstep, voffA); PG8_STAGE(PG8_SB(1, 1), cB + hstep + kstep, voffB);
        PG8_WAIT_V(6); PG8_BAR;
    }
    for (;;) {
        const bool has_next = S.next(ui + 1, nxt);
        const char* nA = has_next ? (const char*)g.A + (size_t)nxt.pm * tstep : cA; const char* nB = has_next ? (const char*)g.Bt + (size_t)nxt.pn * tstep : cB;
        for (int t = 0; t < nt; t += 2) {
            const bool last = (t == nt - 2);
            const char* a1 = cA + (size_t)(t + 1) * kstep;
            const char* a2 = last ? nA : cA + (size_t)(t + 2) * kstep; const char* b2 = last ? nB : cB + (size_t)(t + 2) * kstep;
            const char* a3 = a2 + kstep; const char* b3 = b2 + kstep;
            if (last && has_next) S.a_ready(nxt);
            if constexpr (SP2) {
            PG8_LDB(B0, 0, 0); PG8_LDB(B1, 0, 1); PG8_SCHED; PG8_LDA(At, 0, 0); PG8_STAGE(PG8_SA(1, 1), a1 + hstep, voffA);
            PG8_WAIT_V(8); PG8_WAIT_L(0); PG8_BAR; PG8_MMA(0, 0, At, B0); PG8_MMA(0, 1, At, B1); PG8_BAR; PG8_SCHED;
            PG8_LDA(At, 0, 1); PG8_STAGE(PG8_SB(0, 0), b2, voffB); PG8_STAGE(PG8_SB(0, 1), b2 + hstep, voffB); PG8_STAGE(PG8_SA(0, 0), a2, voffA);
            PG8_WAIT_V(8); PG8_WAIT_L(0); PG8_BAR; PG8_MMA(1, 0, At, B0); PG8_MMA(1, 1, At, B1); PG8_BAR; PG8_SCHED;
            PG8_LDB(B0, 1, 0); PG8_LDB(B1, 1, 1); PG8_SCHED; PG8_LDA(At, 1, 0); PG8_STAGE(PG8_SA(0, 1), a2 + hstep, voffA);
            PG8_WAIT_V(8); PG8_WAIT_L(0); PG8_BAR; PG8_MMA(0, 0, At, B0); PG8_MMA(0, 1, At, B1); PG8_BAR; PG8_SCHED;
            PG8_LDA(At, 1, 1); PG8_STAGE(PG8_SB(1, 0), b3, voffB); PG8_STAGE(PG8_SB(1, 1), b3 + hstep, voffB); PG8_STAGE(PG8_SA(1, 0), a3, voffA);
            PG8_WAIT_V(8); PG8_WAIT_L(0); PG8_BAR; PG8_MMA(1, 0, At, B0); PG8_MMA(1, 1, At, B1); PG8_BAR; PG8_SCHED;
            } else {
            PG8_LDB(B0, 0, 0); PG8_SCHED; PG8_LDA(At, 0, 0); PG8_STAGE(PG8_SA(1, 1), a1 + hstep, voffA);
            PG8_WAIT_L(8); PG8_BAR; PG8_WAIT_L(0); PG8_MMA(0, 0, At, B0); PG8_BAR; PG8_SCHED;
            PG8_LDB(B1, 0, 1); PG8_STAGE(PG8_SB(0, 0), b2, voffB);
            PG8_BAR; PG8_WAIT_L(0); PG8_MMA(0, 1, At, B1); PG8_BAR;
            PG8_LDA(At, 0, 1); PG8_STAGE(PG8_SA(0, 0), a2, voffA);
            PG8_BAR; PG8_WAIT_L(0); PG8_MMA(1, 0, At, B0); PG8_BAR; PG8_SCHED;
            PG8_STAGE(PG8_SB(0, 1), b2 + hstep, voffB);
            PG8_WAIT_V(6); PG8_BAR; PG8_MMA(1, 1, At, B1); PG8_BAR;
            PG8_LDB(B0, 1, 0); PG8_SCHED; PG8_LDA(At, 1, 0); PG8_STAGE(PG8_SA(0, 1), a2 + hstep, voffA);
            PG8_WAIT_L(8); PG8_BAR; PG8_WAIT_L(0); PG8_MMA(0, 0, At, B0); PG8_BAR; PG8_SCHED;
            PG8_LDB(B1, 1, 1); PG8_STAGE(PG8_SB(1, 0), b3, voffB);
            PG8_BAR; PG8_WAIT_L(0); PG8_MMA(0, 1, At, B1); PG8_BAR;
            PG8_LDA(At, 1, 1); PG8_STAGE(PG8_SA(1, 0), a3, voffA);
            PG8_BAR; PG8_WAIT_L(0); PG8_MMA(1, 0, At, B0); PG8_BAR; PG8_SCHED;
            PG8_STAGE(PG8_SB(1, 1), b3 + hstep, voffB);
            PG8_WAIT_V(6); PG8_BAR; PG8_MMA(1, 1, At, B1); PG8_BAR;
            }
        }
        if constexpr (ALIGN_EPI) { if (wr == 0) PG8_BAR; }
        if constexpr (!Epi::AFTER_DRAIN) { E(acc, cur, wr, wc, fr, fq); S.done(cur); }
        if (!has_next) break;
#pragma unroll
        for (int a = 0; a < 2; ++a)
#pragma unroll
            for (int b = 0; b < 2; ++b)
#pragma unroll
                for (int m = 0; m < 4; ++m)
#pragma unroll
                    for (int n = 0; n < 2; ++n) acc[a][b][m][n] = (f32x4){0.f, 0.f, 0.f, 0.f};
        cur = nxt; cA = nA; cB = nB; ++ui;
        if constexpr (ALIGN_EPI) { if (wr == 1) PG8_BAR; }
    }
    PG8_WAIT_V(0);
    if constexpr (!ALIGN_EPI) { if (wr == 0) PG8_BAR; }
    PG8_BAR;
    if constexpr (Epi::AFTER_DRAIN) { E.fused(acc, cur, wr, wc, fr, fq, lds, wid, lane); S.done(cur); }
#undef PG8_SA
#undef PG8_SB
#undef PG8_STAGE
#undef PG8_LDA
#undef PG8_LDB
#undef PG8_MMA
#undef PG8_WAIT_V
#undef PG8_WAIT_L
#undef PG8_BAR
#undef PG8_SCHED
}
}

constexpr int NWAVES = 8, NTHR = 512;
constexpr int NTOK = 8192, SEQ = 4096, DM = 2048, IN_COLS = 11520, RW = 1024, ZRC = 3328;
constexpr size_t MiB = 1u << 20;
constexpr size_t WS_CTL = 0, CTL_ZERO_BYTES = 128 * 1024;
constexpr size_t WS_SBRW = 112 * 1024;
constexpr size_t WS_SAR = 490 * MiB + 64 * 1024, WS_SAW = 490 * MiB + 128 * 1024;
constexpr size_t WS_SBM = 64 * 1024, WS_SA = 490 * MiB;
constexpr size_t WS_KEYS = 1 * MiB;
constexpr size_t WS_WLORA = 2 * MiB;
constexpr size_t WS_ROT = 4 * MiB;
constexpr size_t WS_WR = 8 * MiB, WS_WW = 12 * MiB, WS_WO = 16 * MiB, WS_WQ = 24 * MiB;
constexpr size_t WS_GB = 32 * MiB;
constexpr size_t WS_SG = 48 * MiB;
constexpr size_t WS_QB = 112 * MiB, WS_KB = 128 * MiB;
constexpr size_t WS_KT = 144 * MiB, WS_VT = 160 * MiB, WS_VDT = 176 * MiB;
constexpr size_t WS_RKV = 192 * MiB;
constexpr size_t WS_DEC = 240 * MiB;
constexpr size_t WS_AB = 272 * MiB, WS_GG = 288 * MiB;
constexpr size_t WS_Y = 304 * MiB;
constexpr size_t WS_ORET = 336 * MiB;
constexpr size_t WS_VR = 352 * MiB;
constexpr size_t WS_WIN = 368 * MiB;
constexpr size_t WS_ZR = 413 * MiB;
constexpr size_t WS_H = 465 * MiB;
constexpr size_t WS_L = 368 * MiB;
constexpr size_t WS_U8 = 368 * MiB, WS_V8 = 413 * MiB, WS_SCU = 352 * MiB, WS_SCV = 353 * MiB;
constexpr size_t WS_KV = 448 * MiB;
constexpr int CW_GBAR = 8192;
constexpr size_t WS_UB = 368 * MiB, WS_VB = 432 * MiB;
constexpr size_t WS_ORN = 144 * MiB, WS_OWN = 160 * MiB;
constexpr size_t WS_M1 = 192 * MiB;
constexpr size_t WS_MG = 256 * MiB;
constexpr size_t WS_H2 = 112 * MiB;
constexpr size_t WS_QP = 144 * MiB;
constexpr size_t WS_SC = 192 * MiB;
constexpr size_t WS_H2Q = 256 * MiB, WS_SX = 272 * MiB;
constexpr size_t WS_PART = 354 * MiB;
constexpr size_t WS_WQK = 356 * MiB;
constexpr size_t WS_END = 512 * MiB;

constexpr int RING_BYTES = 131072, LDSCTL_OFF = RING_BYTES, MISC_OFF = LDSCTL_OFF + 320, LDS_BYTES = 147456;
constexpr int CW_BAR = 4096;

#define GAS __attribute__((address_space(1)))
#define LAS __attribute__((address_space(3)))
typedef unsigned short bf16;
typedef unsigned v4u __attribute__((ext_vector_type(4)));
typedef unsigned v2u __attribute__((ext_vector_type(2)));
typedef float f32x4 __attribute__((ext_vector_type(4)));
typedef short bf16x8 __attribute__((ext_vector_type(8)));
typedef __bf16 bf16x2v __attribute__((ext_vector_type(2)));
typedef GAS unsigned gu32;
#define LDS_WAIT() asm volatile("s_waitcnt lgkmcnt(0)" ::: "memory")
#define VM_WAIT() asm volatile("s_waitcnt vmcnt(0)" ::: "memory")
__device__ __forceinline__ unsigned f2bf(float f) { unsigned u = __builtin_bit_cast(unsigned, f); return (u + 0x7fffu + ((u >> 16) & 1u)) >> 16; }
__device__ __forceinline__ unsigned pk2(float lo, float hi) { return f2bf(lo) | (f2bf(hi) << 16); }
__device__ __forceinline__ float bflo(unsigned u) { return __uint_as_float(u << 16); }
__device__ __forceinline__ float bfhi(unsigned u) { return __uint_as_float(u & 0xffff0000u); }
__device__ __forceinline__ float bf1(bf16 b) { return __uint_as_float(((unsigned)b) << 16); }
__device__ __forceinline__ float sigm(float v) { return 1.0f / (1.0f + __expf(-v)); }
template <int CTRL> __device__ __forceinline__ float dppf(float x) { return __builtin_bit_cast(float, __builtin_amdgcn_update_dpp(0, __builtin_bit_cast(int, x), CTRL, 0xf, 0xf, false)); }
template <int CTRL> __device__ __forceinline__ int dppi(int x) { return __builtin_amdgcn_update_dpp(0, x, CTRL, 0xf, 0xf, false); }
__device__ __forceinline__ float rowsum16(float x) { x += dppf<0x128>(x); x += dppf<0x124>(x); x += dppf<0x122>(x); x += dppf<0x121>(x); return x; }
__device__ __forceinline__ float rowmax16(float x) { x = fmaxf(x, dppf<0x128>(x)); x = fmaxf(x, dppf<0x124>(x)); x = fmaxf(x, dppf<0x122>(x)); x = fmaxf(x, dppf<0x121>(x)); return x; }
__device__ __forceinline__ float quadsum(float x) { x += dppf<0xB1>(x); x += dppf<0x4E>(x); return x; }
__device__ __forceinline__ float wave_sum(float v) { v = rowsum16(v); v += __shfl_xor(v, 16); v += __shfl_xor(v, 32); return v; }
__device__ __forceinline__ float wave_max(float v) { v = rowmax16(v); v = fmaxf(v, __shfl_xor(v, 16)); v = fmaxf(v, __shfl_xor(v, 32)); return v; }
__device__ __forceinline__ float dot2bf(unsigned w, unsigned x, float acc) { return __builtin_amdgcn_fdot2_f32_bf16(__builtin_bit_cast(bf16x2v, w), __builtin_bit_cast(bf16x2v, x), acc, false); }
__device__ __forceinline__ f32x4 mfma16(bf16x8 a, bf16x8 b, f32x4 c) { return __builtin_amdgcn_mfma_f32_16x16x32_bf16(a, b, c, 0, 0, 0); }
__device__ __forceinline__ float gelu_erf(float v) {
    const float av = fabsf(v), t = __builtin_amdgcn_rcpf(av * 0.2316418882f + 1.0f);
    float q = t * 0.5307027145f + (-0.7265760135f); q = q * t + 0.7107068705f; q = q * t + (-0.142248368f); q = q * t + 0.127414796f; q = q * t;
    const float e = __builtin_amdgcn_exp2f((v * v) * (-0.72134752044f)); const float m = v * (q * e);
    return v < 0.f ? m : v - m;
}

#define XB_TMO      128
#define XB_XCNT(j)  (256  + 64 * (j))
#define XB_XSUB(j)  (1280 + 64 * (j))
#define XB_XGEN(j)  (2304 + 64 * (j))
#define XB_TOP      3328
#define XB_TOPGEN   3392
#define XCD_BAR_WORDS 3456
#define XB_SPIN_CAP (1u << 18)

__device__ __forceinline__ unsigned xb_ld(unsigned* p)              { return __hip_atomic_load(p, __ATOMIC_RELAXED, __HIP_MEMORY_SCOPE_AGENT); }
__device__ __forceinline__ unsigned xb_add(unsigned* p, unsigned v) { return __hip_atomic_fetch_add(p, v, __ATOMIC_RELAXED, __HIP_MEMORY_SCOPE_AGENT); }
__device__ __forceinline__ unsigned xb_xcc_id() { return (unsigned)__builtin_amdgcn_s_getreg((3 << 11) | 20) & 0xFu; }
#define XB_SPIN(cond, bar) do { unsigned _sp = 0; while (cond) { __builtin_amdgcn_s_sleep(1); \
    if ((++_sp & 255u) == 0u) { if (xb_ld(&(bar)[XB_TMO])) break; if (_sp > XB_SPIN_CAP) { atomicAdd(&(bar)[XB_TMO], 1u); break; } } } } while (0)

struct XcdBarrier {
    unsigned* bar; unsigned x;
    volatile LAS unsigned* st;
};

__device__ __forceinline__ XcdBarrier xcd_barrier_post(unsigned* bar, volatile LAS unsigned* st) {
    XcdBarrier b; b.bar = bar; b.x = xb_xcc_id(); b.st = st;
    if (threadIdx.x == 0) (void)xb_add(&bar[XB_XCNT(b.x)], 1u);
    return b;
}
__device__ __forceinline__ void xcd_barrier_complete(unsigned* bar, unsigned x, unsigned& nloc, unsigned& nx) {
    const unsigned G = gridDim.x * gridDim.y * gridDim.z;
    unsigned sum, cnt, mine, sp = 0u;
    for (;;) {
        sum = 0u; cnt = 0u; mine = 0u;
#pragma unroll
        for (unsigned j = 0; j < 16; ++j) { const unsigned c = xb_ld(&bar[XB_XCNT(j)]); sum += c; cnt += (c > 0u) ? 1u : 0u; mine = (j == x) ? c : mine; }
        if (sum == G) break;
        __builtin_amdgcn_s_sleep(1);
        if ((++sp & 255u) == 0u) { if (xb_ld(&bar[XB_TMO])) break; if (sp > XB_SPIN_CAP) { atomicAdd(&bar[XB_TMO], 1u); break; } }
    }
    nloc = mine > 0u ? mine : 1u; nx = cnt > 0u ? cnt : 1u;
}

__device__ __forceinline__ void xcd_barrier(const XcdBarrier& b) {
    asm volatile("s_waitcnt vmcnt(0)" ::: "memory");
    __syncthreads();
    if (threadIdx.x == 0) {
        unsigned* bar = b.bar;
        __builtin_amdgcn_s_waitcnt(0);
        unsigned nloc = b.st[0], nx = b.st[1];
        if (nloc == 0u) { xcd_barrier_complete(bar, b.x, nloc, nx); b.st[0] = nloc; b.st[1] = nx; }
        const unsigned old = xb_add(&bar[XB_XSUB(b.x)], 1u);
        const unsigned gen = old / nloc;
        if (old + 1u == (gen + 1u) * nloc) {
            __builtin_amdgcn_fence(__ATOMIC_RELEASE, "agent");
            asm volatile("s_waitcnt vmcnt(0)" ::: "memory");
            const unsigned og = xb_add(&bar[XB_TOP], 1u);
            const unsigned tg = og / nx;
            if (og + 1u == (tg + 1u) * nx) xb_add(&bar[XB_TOPGEN], 1u);
            else XB_SPIN(xb_ld(&bar[XB_TOPGEN]) == tg, bar);
            __builtin_amdgcn_fence(__ATOMIC_ACQUIRE, "agent");
            xb_add(&bar[XB_XGEN(b.x)], 1u);
            asm volatile("s_waitcnt vmcnt(0)" ::: "memory");
        } else {
            XB_SPIN(xb_ld(&bar[XB_XGEN(b.x)]) == gen, bar);
            __builtin_amdgcn_fence(__ATOMIC_ACQUIRE, "agent");
            asm volatile("s_waitcnt vmcnt(0)" ::: "memory");
        }
    }
    __syncthreads();
}


struct Args { const float* in[26]; float* out; unsigned char* ws; int ph_lo, ph_hi; };

__device__ __forceinline__ void p0_transpose_item(const float* W, int N, bf16* WT, int ldt, int row_off, int col_off, LAS float* scr, int item, int lane) {
    const int nblk = N / 32, kb = item / nblk, nb = item % nblk, k0 = 64 * kb, n0 = 32 * nb;
#pragma unroll 8
    for (int i = 0; i < 32; ++i) { const int kk = 2 * i + (lane >> 5); scr[kk * 33 + (lane & 31)] = W[(size_t)(k0 + kk) * N + n0 + (lane & 31)]; }
    LDS_WAIT(); asm volatile("" ::: "memory");
    const int c = lane & 7;
#pragma unroll
    for (int j = 0; j < 4; ++j) { const int n = (lane >> 3) + 8 * j; const LAS float* s = scr + (8 * c) * 33 + n;
        v4u o; o.x = pk2(s[0 * 33], s[1 * 33]); o.y = pk2(s[2 * 33], s[3 * 33]); o.z = pk2(s[4 * 33], s[5 * 33]); o.w = pk2(s[6 * 33], s[7 * 33]);
        *(GAS v4u*)(WT + (size_t)(row_off + n0 + n) * ldt + col_off + k0 + 8 * c) = o; }
    LDS_WAIT(); asm volatile("" ::: "memory");
}
__device__ __forceinline__ void rms_row_to_bf16(const float* xrow, const float* w, bf16* orow, int lane) {
    const GAS f32x4* xr = (const GAS f32x4*)xrow + lane; const GAS f32x4* wr = (const GAS f32x4*)w + lane;
    f32x4 v[8]; float s = 0.f;
#pragma unroll
    for (int j = 0; j < 8; ++j) { v[j] = xr[64 * j]; s += (v[j].x * v[j].x + v[j].y * v[j].y) + (v[j].z * v[j].z + v[j].w * v[j].w); }
    const float r = 1.0f / sqrtf(wave_sum(s) * (1.f / 2048.f) + 1e-6f);
    GAS v2u* o8 = (GAS v2u*)orow + lane;
#pragma unroll
    for (int j = 0; j < 8; ++j) { const f32x4 ww = wr[64 * j]; v2u o; o.x = pk2(v[j].x * r * ww.x, v[j].y * r * ww.y); o.y = pk2(v[j].z * r * ww.z, v[j].w * r * ww.w); o8[64 * j] = o; }
}
__device__ __forceinline__ void rms_row_to_bf16_i8(const float* xrow, const float* w, bf16* orow, unsigned char* qrow, float* qscale, int lane) {
    const GAS f32x4* xr = (const GAS f32x4*)xrow + lane; const GAS f32x4* wr = (const GAS f32x4*)w + lane;
    f32x4 v[8]; float s = 0.f;
#pragma unroll
    for (int j = 0; j < 8; ++j) { v[j] = xr[64 * j]; s += (v[j].x * v[j].x + v[j].y * v[j].y) + (v[j].z * v[j].z + v[j].w * v[j].w); }
    const float r = 1.0f / sqrtf(wave_sum(s) * (1.f / 2048.f) + 1e-6f);
    GAS v2u* o8 = (GAS v2u*)orow + lane; float am = 0.f;
#pragma unroll
    for (int j = 0; j < 8; ++j) { const f32x4 ww = wr[64 * j]; v[j] = v[j] * r * ww; v2u o; o.x = pk2(v[j].x, v[j].y); o.y = pk2(v[j].z, v[j].w); o8[64 * j] = o;
        am = fmaxf(am, fmaxf(fmaxf(fabsf(v[j].x), fabsf(v[j].y)), fmaxf(fabsf(v[j].z), fabsf(v[j].w)))); }
    am = fmaxf(wave_max(am), 1e-30f); const float inv = 127.0f / am;
#pragma unroll
    for (int j = 0; j < 8; ++j) { const unsigned q = ((unsigned)(int)rintf(v[j].x * inv) & 0xffu) | (((unsigned)(int)rintf(v[j].y * inv) & 0xffu) << 8) | (((unsigned)(int)rintf(v[j].z * inv) & 0xffu) << 16) | (((unsigned)(int)rintf(v[j].w * inv) & 0xffu) << 24);
        ((GAS unsigned*)qrow)[64 * j + lane] = q; }
    if (lane == 0) *qscale = am * (1.0f / 127.0f);
}
__device__ __forceinline__ void p0_win_absmax_item(const float* W, int N, unsigned* sbm, int item, int lane) {
    const int nblk = N / 32, kb = item / nblk, nb = item % nblk, k0 = 64 * kb, n0 = 32 * nb; float m = 0.f, wv[32];
#pragma unroll
    for (int i = 0; i < 32; ++i) wv[i] = W[(size_t)(k0 + 2 * i + (lane >> 5)) * N + n0 + (lane & 31)];
#pragma unroll
    for (int i = 0; i < 32; ++i) m = fmaxf(m, fabsf(wv[i]));
    m = fmaxf(m, __shfl_xor(m, 32));
    if (lane < 32) atomicMax(sbm + n0 + lane, __float_as_uint(m));
}
__device__ __forceinline__ void p0_win_i8_item(const float* W, int N, unsigned char* WT, int ldt, const unsigned* sbm, LAS float* scr, int item, int lane) {
    const int nblk = N / 32, kb = item / nblk, nb = item % nblk, k0 = 64 * kb, n0 = 32 * nb;
#pragma unroll 8
    for (int i = 0; i < 32; ++i) { const int kk = 2 * i + (lane >> 5); scr[kk * 33 + (lane & 31)] = W[(size_t)(k0 + kk) * N + n0 + (lane & 31)]; }
    LDS_WAIT(); asm volatile("" ::: "memory");
    const int c = lane & 7;
#pragma unroll
    for (int j = 0; j < 4; ++j) { const int n = (lane >> 3) + 8 * j; const LAS float* s = scr + (8 * c) * 33 + n; const float am = __uint_as_float(sbm[n0 + n]), inv = am > 0.f ? 127.0f / am : 0.f;
        unsigned q[2];
#pragma unroll
        for (int hh = 0; hh < 2; ++hh) q[hh] = ((unsigned)(int)rintf(s[(4 * hh) * 33] * inv) & 0xffu) | (((unsigned)(int)rintf(s[(4 * hh + 1) * 33] * inv) & 0xffu) << 8) | (((unsigned)(int)rintf(s[(4 * hh + 2) * 33] * inv) & 0xffu) << 16) | (((unsigned)(int)rintf(s[(4 * hh + 3) * 33] * inv) & 0xffu) << 24);
        v2u o; o.x = q[0]; o.y = q[1];
        *(GAS v2u*)(WT + (size_t)(n0 + n) * ldt + k0 + 8 * c) = o; }
    LDS_WAIT(); asm volatile("" ::: "memory");
}
__device__ __forceinline__ void rms_row_to_i8(const float* xrow, const float* w, unsigned char* qrow, float* qscale, int lane) {
    const GAS f32x4* xr = (const GAS f32x4*)xrow + lane; const GAS f32x4* wr = (const GAS f32x4*)w + lane;
    f32x4 v[8]; float s = 0.f;
#pragma unroll
    for (int j = 0; j < 8; ++j) { v[j] = xr[64 * j]; s += (v[j].x * v[j].x + v[j].y * v[j].y) + (v[j].z * v[j].z + v[j].w * v[j].w); }
    const float r = 1.0f / sqrtf(wave_sum(s) * (1.f / 2048.f) + 1e-6f); float am = 0.f;
#pragma unroll
    for (int j = 0; j < 8; ++j) { const f32x4 ww = wr[64 * j]; v[j] = v[j] * r * ww; am = fmaxf(am, fmaxf(fmaxf(fabsf(v[j].x), fabsf(v[j].y)), fmaxf(fabsf(v[j].z), fabsf(v[j].w)))); }
    am = fmaxf(wave_max(am), 1e-30f); const float inv = 127.0f / am;
#pragma unroll
    for (int j = 0; j < 8; ++j) { const unsigned q = ((unsigned)(int)rintf(v[j].x * inv) & 0xffu) | (((unsigned)(int)rintf(v[j].y * inv) & 0xffu) << 8) | (((unsigned)(int)rintf(v[j].z * inv) & 0xffu) << 16) | (((unsigned)(int)rintf(v[j].w * inv) & 0xffu) << 24);
        ((GAS unsigned*)qrow)[64 * j + lane] = q; }
    if (lane == 0) *qscale = am * (1.0f / 127.0f);
}
__device__ __forceinline__ void p0_win_strip(const Args& A, LAS unsigned char* lds, int strip, int tid) {
    const int lane = tid & 63, wave = tid >> 6, n = lane & 31, half = lane >> 5; unsigned char* ws = A.ws;
    const float* W = A.in[2] + strip * 32 + n;
    LAS unsigned* T = (LAS unsigned*)lds; LAS float* cm = (LAS float*)(lds + LDSCTL_OFF + 4096);
    float m = 0.f;
#pragma unroll 1
    for (int i0 = 0; i0 < 64; i0 += 16) { float a[16], b[16];
#pragma unroll
        for (int i = 0; i < 16; ++i) { const int k = 256 * wave + 4 * (i0 + i) + 2 * half; a[i] = W[(size_t)k * IN_COLS]; b[i] = W[(size_t)(k + 1) * IN_COLS]; }
#pragma unroll
        for (int i = 0; i < 16; ++i) { const unsigned w2 = pk2(a[i], b[i]); m = fmaxf(m, fmaxf(fabsf(bflo(w2)), fabsf(bfhi(w2)))); const int k2 = 128 * wave + 2 * (i0 + i) + half; T[n * 1024 + ((k2 + n) & 1023)] = w2; } }
    m = fmaxf(m, __shfl_xor(m, 32)); if (half == 0) cm[wave * 32 + n] = m;
    __syncthreads();
    if (tid < 32) { float f = 0.f;
#pragma unroll
        for (int w = 0; w < 8; ++w) f = fmaxf(f, cm[w * 32 + tid]);
        cm[256 + tid] = f; ((unsigned*)(ws + WS_CTL + WS_SBM))[strip * 32 + tid] = __float_as_uint(f); }
    __syncthreads();
    unsigned char* WT = ws + WS_WIN + (size_t)strip * 32 * 2048;
#pragma unroll 4
    for (int j = 0; j < 16; ++j) { const int g = tid + NTHR * j, n2 = g >> 8, k8 = g & 255; const float am = cm[256 + n2], inv = am > 0.f ? 127.0f / am : 0.f; unsigned q[2];
#pragma unroll
        for (int hh = 0; hh < 2; ++hh) { const unsigned w0 = T[n2 * 1024 + ((4 * k8 + 2 * hh + n2) & 1023)], w1 = T[n2 * 1024 + ((4 * k8 + 2 * hh + 1 + n2) & 1023)];
            q[hh] = ((unsigned)(int)rintf(bflo(w0) * inv) & 0xffu) | (((unsigned)(int)rintf(bfhi(w0) * inv) & 0xffu) << 8) | (((unsigned)(int)rintf(bflo(w1) * inv) & 0xffu) << 16) | (((unsigned)(int)rintf(bfhi(w1) * inv) & 0xffu) << 24); }
        v2u o; o.x = q[0]; o.y = q[1]; *(GAS v2u*)(WT + (size_t)n2 * 2048 + k8 * 8) = o; }
    __syncthreads();
}
__device__ __forceinline__ void p0b_win(const Args& A, LAS unsigned char* lds, int vcu, int G, int tid) {
    const int lane = tid & 63, wave = tid >> 6; unsigned char* ws = A.ws; LAS float* scr = (LAS float*)(lds + wave * 16384);
    for (int it = vcu * NWAVES + wave; it < 32 * 360; it += G * NWAVES) p0_win_i8_item(A.in[2], IN_COLS, ws + WS_WIN, 2048, (const unsigned*)(ws + WS_CTL + WS_SBM), scr, it, lane);
}
__device__ __forceinline__ void p4_wq_copy(const Args& A, int bi, int nb, int tid) {
    bf16* WQH = (bf16*)(A.ws + WS_WQ); const float* wq = A.in[20];
    for (int i = bi * NTHR + tid; i < 2048 * 2048 / 4; i += nb * NTHR) { const int k = i >> 9, hc = (i & 511) * 4, hd = hc >> 8, c = hc & 255; const f32x4 t = *(const GAS f32x4*)(wq + (size_t)k * 2048 + hc);
        v2u o; o.x = pk2(t.x, t.y); o.y = pk2(t.z, t.w); *(GAS v2u*)(WQH + ((size_t)hd * 2048 + k) * 256 + c) = o; }
}
__device__ __forceinline__ void p4_w_absmax(const Args& A, int bi, int nb, int tid) {
    const int lane = tid & 63, wave = tid >> 6; unsigned* sbrw = (unsigned*)(A.ws + WS_CTL + WS_SBRW);
    for (int it = bi * NWAVES + wave; it < 2 * 1024; it += nb * NWAVES) p0_win_absmax_item(A.in[16 + (it >> 10)], 2048, sbrw + 2048 * (it >> 10), it & 1023, lane);
}
__device__ __forceinline__ void p4_weight_transposes(const Args& A, LAS unsigned char* lds, int bi, int nb, int tid) {
    const int lane = tid & 63, wave = tid >> 6; unsigned char* ws = A.ws; LAS float* scr = (LAS float*)(lds + wave * 16384);
    constexpr int I_B = 16 * 64, I_O = 32 * 64;
    const unsigned* sbrw = (const unsigned*)(ws + WS_CTL + WS_SBRW);
    for (int it = bi * NWAVES + wave; it < 2 * I_B + I_O; it += nb * NWAVES) { int r = it;
        if (r < I_B) { p0_win_i8_item(A.in[16], 2048, ws + WS_WR, 1024, sbrw, scr, r, lane); continue; } r -= I_B;
        if (r < I_B) { p0_win_i8_item(A.in[17], 2048, ws + WS_WW, 1024, sbrw + 2048, scr, r, lane); continue; } r -= I_B;
        p0_transpose_item(A.in[18], 2048, (bf16*)(ws + WS_WO), 2048, 0, 0, scr, r, lane); }
}
__device__ __forceinline__ void p0_prologue(const Args& A, LAS unsigned char* lds, int vcu, int G, int tid) {
    const int lane = tid & 63, wave = tid >> 6;
    unsigned char* ws = A.ws;
    LAS float* scr = (LAS float*)(lds + wave * 16384);
    const int gw = vcu * NWAVES + wave, NGW = G * NWAVES;
    constexpr int I_IN = 32 * 360, I_B = 16 * 64, I_O = 32 * 64, I_L = 32;
    constexpr int NITEMS = I_IN + 2 * I_B + 2 * I_O + 4 * I_L;
    for (int it = gw; it < NITEMS; it += NGW) {
        int r = it;
        if (r < I_IN) { continue; } r -= I_IN;
        if (r < 2 * I_B + I_O) { continue; } r -= 2 * I_B + I_O;
        if (r < I_O) { continue; } r -= I_O;
        if (r < I_L) { p0_transpose_item(A.in[7], 1024, (bf16*)(ws + WS_WLORA), 256, 0, 0, scr, r, lane); continue; } r -= I_L;
        if (r < I_L) { p0_transpose_item(A.in[9], 1024, (bf16*)(ws + WS_WLORA), 256, 1024, 64, scr, r, lane); continue; } r -= I_L;
        p0_transpose_item(A.in[10], 1024, (bf16*)(ws + WS_WLORA), 256, 2048, 128, scr, r, lane);
    }
    const int gt = vcu * NTHR + tid, NGT = G * NTHR;
    { bf16* WL = (bf16*)(ws + WS_WLORA);
      for (int i = gt; i < 3072 * 256; i += NGT) { const int r = i >> 8, c = i & 255; const bool nz = (r < 1024) ? (c < 64) : (r < 2048) ? (c >= 64 && c < 128) : (c >= 128); if (!nz) WL[i] = 0; } }
    { bf16* KB = (bf16*)(ws + WS_KEYS); const float* k1 = A.in[21]; const float* k2 = A.in[22];
      for (int i = gt; i < 256 * 256; i += NGT) { const int r = i >> 8, c = i & 255; float v = 0.f; if (r < 128 && c < 128) v = k1[r * 128 + c]; else if (r >= 128 && c >= 128) v = k2[(r - 128) * 128 + (c - 128)]; KB[i] = (bf16)f2bf(v); } }
    { float* rc = (float*)(ws + WS_ROT); float* rs = rc + 4096 * 128;
      for (int i = gt; i < 4096 * 128; i += NGT) { const int pos = i >> 7, j = i & 127; const float inv = exp2f(-(float)j * 0.10381025296523008f);
          double rev = (double)((float)pos * inv) * 0.15915494309189535; rev -= floor(rev); const float fr = (float)rev;
          rc[i] = __builtin_amdgcn_cosf(fr); rs[i] = __builtin_amdgcn_sinf(fr); } }
    for (int m = gw; m < NTOK; m += NGW) rms_row_to_i8(A.in[0] + (size_t)m * DM, A.in[1], ws + WS_H + (size_t)m * DM, (float*)(ws + WS_SA) + m, lane);
}

__device__ __forceinline__ void p2a_lerp(const Args& A, int vcu, int G, int tid) {
    const int lane = tid & 63, wave = tid >> 6; unsigned char* ws = A.ws;
    const bf16* Zr = (const bf16*)(ws + WS_ZR); bf16* RKV = (bf16*)(ws + WS_RKV); bf16* L = (bf16*)(ws + WS_L); const float* mix = A.in[5];
    const int gw = vcu * NWAVES + wave, NGW = G * NWAVES;
    for (int n = gw; n < NTOK; n += NGW) { const int t = n & (SEQ - 1);
        for (int v = lane; v < ZRC / 8; v += 64) { const int c0 = 8 * v;
            const v4u zz = *(const GAS v4u*)(Zr + (size_t)n * ZRC + c0); v4u zp = {0u, 0u, 0u, 0u}; if (t > 0) zp = *(const GAS v4u*)(Zr + (size_t)(n - 1) * ZRC + c0);
            const f32x4 m0 = *(const GAS f32x4*)(mix + c0), m1 = *(const GAS f32x4*)(mix + c0 + 4);
            float z[8], p[8], mx[8] = {m0.x, m0.y, m0.z, m0.w, m1.x, m1.y, m1.z, m1.w};
            z[0] = bflo(zz.x); z[1] = bfhi(zz.x); z[2] = bflo(zz.y); z[3] = bfhi(zz.y); z[4] = bflo(zz.z); z[5] = bfhi(zz.z); z[6] = bflo(zz.w); z[7] = bfhi(zz.w);
            p[0] = bflo(zp.x); p[1] = bfhi(zp.x); p[2] = bflo(zp.y); p[3] = bfhi(zp.y); p[4] = bflo(zp.z); p[5] = bfhi(zp.z); p[6] = bflo(zp.w); p[7] = bfhi(zp.w);
#pragma unroll
            for (int j = 0; j < 8; ++j) z[j] = z[j] + (p[j] - z[j]) * mx[j];
            bf16* dst;
            if (c0 < 3072) dst = RKV + (size_t)n * 3072 + c0;
            else if (c0 < 3136) { dst = L + (size_t)n * 256 + (c0 - 3072);
#pragma unroll
                for (int j = 0; j < 8; ++j) z[j] = 1.0f - 2.0f / (1.0f + __expf(2.0f * z[j])); }
            else if (c0 < 3200) dst = L + (size_t)n * 256 + 64 + (c0 - 3136);
            else { dst = L + (size_t)n * 256 + 128 + (c0 - 3200);
#pragma unroll
                for (int j = 0; j < 8; ++j) z[j] = sigm(z[j]); }
            v4u o; o.x = pk2(z[0], z[1]); o.y = pk2(z[2], z[3]); o.z = pk2(z[4], z[5]); o.w = pk2(z[6], z[7]);
            *(GAS v4u*)dst = o; } }
}
__device__ __forceinline__ float ret_log2g(int h) { return log2f(1.0f - exp2f(-5.0f - (float)h)); }
__device__ __forceinline__ void p2a_ret_transpose(const Args& A, LAS unsigned char* lds, int vcu, int G, int tid) {
    const int lane = tid & 63, wave = tid >> 6; unsigned char* ws = A.ws;
    LAS bf16* scr = (LAS bf16*)(lds + wave * 16384);
    const int gw = vcu * NWAVES + wave, NGW = G * NWAVES;
    for (int it = gw; it < 2 * 8 * 64 * 4; it += NGW) {
        const int which = it >> 11, bh = (it >> 8) & 7, c = (it >> 2) & 63, db = it & 3, b = bh >> 2, h = bh & 3;
        const bf16* src = (const bf16*)(ws + (which ? WS_VR : WS_KB)) + (size_t)(b * SEQ + c * 64) * 1024 + h * 256 + db * 64;
#pragma unroll 8
        for (int m = 0; m < 64; ++m) scr[m * 66 + lane] = src[(size_t)m * 1024 + lane];
        LDS_WAIT(); asm volatile("" ::: "memory");
        bf16* d0 = (bf16*)(ws + (which ? WS_VT : WS_KT)) + (size_t)(bh * 64 + c) * 256 * 64;
        bf16* d1 = (bf16*)(ws + WS_VDT) + (size_t)(bh * 64 + c) * 256 * 64;
        const int ch = lane & 7, m0 = 8 * ch; const float l2g = ret_log2g(h);
#pragma unroll
        for (int j = 0; j < 8; ++j) { const int d = (lane >> 3) + 8 * j; float f[8];
            const size_t fo = (size_t)(((((db * 4 + (d >> 4)) * 2 + (ch >> 2)) * 4 + (ch & 3)) * 16 + (d & 15)) * 8);
#pragma unroll
            for (int i = 0; i < 8; ++i) f[i] = bf1(scr[(m0 + i) * 66 + d]);
            v4u o; o.x = pk2(f[0], f[1]); o.y = pk2(f[2], f[3]); o.z = pk2(f[4], f[5]); o.w = pk2(f[6], f[7]);
            *(GAS v4u*)(d0 + fo) = o;
            if (which) {
#pragma unroll
                for (int i = 0; i < 8; ++i) f[i] *= exp2f(l2g * (float)(63 - (m0 + i)));
                o.x = pk2(f[0], f[1]); o.y = pk2(f[2], f[3]); o.z = pk2(f[4], f[5]); o.w = pk2(f[6], f[7]);
                *(GAS v4u*)(d1 + fo) = o; } }
        LDS_WAIT(); asm volatile("" ::: "memory");
    }
}

__device__ __forceinline__ void group_barrier(unsigned* cnt, unsigned target, int tid) {
    asm volatile("s_waitcnt vmcnt(0)" ::: "memory"); __syncthreads();
    if (tid == 0) {
        __builtin_amdgcn_fence(__ATOMIC_RELEASE, "agent"); asm volatile("s_waitcnt vmcnt(0)" ::: "memory");
        __hip_atomic_fetch_add(cnt, 1u, __ATOMIC_RELAXED, __HIP_MEMORY_SCOPE_AGENT);
        unsigned sp = 0; while (__hip_atomic_load(cnt, __ATOMIC_RELAXED, __HIP_MEMORY_SCOPE_AGENT) < target) { __builtin_amdgcn_s_sleep(2); if (++sp > (1u << 22)) break; }
        __builtin_amdgcn_fence(__ATOMIC_ACQUIRE, "agent"); asm volatile("s_waitcnt vmcnt(0)" ::: "memory");
    }
    __syncthreads();
}
struct RetA { const bf16 *Qc, *Kc, *Ktc, *Vtc, *Vdtc; bf16 *KV, *Oret; LAS bf16* Pl; size_t tok0; float l2g; int h; };
__device__ __forceinline__ RetA ret_a_setup(const Args& A, LAS unsigned char* lds, int bh, int c, int slot) {
    unsigned char* ws = A.ws; RetA U; const int b = bh >> 2, h = bh & 3; U.h = h; U.l2g = ret_log2g(h); U.tok0 = (size_t)b * SEQ + c * 64;
    U.Pl = (LAS bf16*)(lds + slot * 9216);
    U.Qc = (const bf16*)(ws + WS_QB) + U.tok0 * 1024 + h * 256; U.Kc = (const bf16*)(ws + WS_KB) + U.tok0 * 1024 + h * 256;
    U.Ktc = (const bf16*)(ws + WS_KT) + (size_t)(bh * 64 + c) * 256 * 64; U.Vtc = (const bf16*)(ws + WS_VT) + (size_t)(bh * 64 + c) * 256 * 64; U.Vdtc = (const bf16*)(ws + WS_VDT) + (size_t)(bh * 64 + c) * 256 * 64;
    U.Oret = (bf16*)(ws + WS_ORET); U.KV = (bf16*)A.out + (size_t)(bh * 64 + c) * 65536;
    return U; }
__device__ __forceinline__ void ret_a_scores(const RetA& U, int tid) {
    const int lane = tid & 63, w = tid >> 6, fr = lane & 15, fq = lane >> 4, nb = w >> 1, mb0 = 2 * (w & 1);
    f32x4 accP[2] = {(f32x4){0.f, 0.f, 0.f, 0.f}, (f32x4){0.f, 0.f, 0.f, 0.f}};
#pragma unroll
    for (int ks = 0; ks < 8; ++ks) { const bf16x8 aq = *(const GAS bf16x8*)(U.Qc + (size_t)(nb * 16 + fr) * 1024 + ks * 32 + fq * 8);
#pragma unroll
        for (int t = 0; t < 2; ++t) { const bf16x8 bk = *(const GAS bf16x8*)(U.Kc + (size_t)((mb0 + t) * 16 + fr) * 1024 + ks * 32 + fq * 8); accP[t] = mfma16(aq, bk, accP[t]); } }
#pragma unroll
    for (int t = 0; t < 2; ++t)
#pragma unroll
        for (int r = 0; r < 4; ++r) { const int n = nb * 16 + 4 * fq + r, m = (mb0 + t) * 16 + fr; const int dd = n > m ? n - m : m - n;
            U.Pl[n * 72 + m] = (bf16)f2bf(accP[t][r] * exp2f(U.l2g * (float)dd)); }
}
__device__ __forceinline__ void ret_a_rest(const RetA& U, int tid) {
    const int lane = tid & 63, w = tid >> 6, fr = lane & 15, fq = lane >> 4, nb = w >> 1;
    {
        bf16x8 pf[2];
#pragma unroll
        for (int ks = 0; ks < 2; ++ks) pf[ks] = *(const LAS bf16x8*)(U.Pl + (nb * 16 + fr) * 72 + ks * 32 + fq * 8);
#pragma unroll
        for (int e8 = 0; e8 < 8; ++e8) { const int eb = (w & 1) * 8 + e8; f32x4 acc = {0.f, 0.f, 0.f, 0.f};
#pragma unroll
            for (int ks = 0; ks < 2; ++ks) { const bf16x8 vf = *(const GAS bf16x8*)(U.Vtc + (size_t)((((eb * 2 + ks) * 4 + fq) * 16 + fr) * 8)); acc = mfma16(vf, pf[ks], acc); }
            v2u o; o.x = pk2(acc[0], acc[1]); o.y = pk2(acc[2], acc[3]);
            *(GAS v2u*)(U.Oret + (U.tok0 + nb * 16 + fr) * 1024 + U.h * 256 + eb * 16 + 4 * fq) = o; }
    }
    {
        bf16x8 kf[2][2];
#pragma unroll
        for (int t = 0; t < 2; ++t)
#pragma unroll
            for (int ks = 0; ks < 2; ++ks) kf[t][ks] = *(const GAS bf16x8*)(U.Ktc + (size_t)(((((2 * w + t) * 2 + ks) * 4 + fq) * 16 + fr) * 8));
#pragma unroll
        for (int eb = 0; eb < 16; ++eb) { bf16x8 vf[2];
#pragma unroll
            for (int ks = 0; ks < 2; ++ks) vf[ks] = *(const GAS bf16x8*)(U.Vdtc + (size_t)((((eb * 2 + ks) * 4 + fq) * 16 + fr) * 8));
#pragma unroll
            for (int t = 0; t < 2; ++t) { f32x4 acc = {0.f, 0.f, 0.f, 0.f};
#pragma unroll
                for (int ks = 0; ks < 2; ++ks) acc = mfma16(kf[t][ks], vf[ks], acc);
                v2u o; o.x = pk2(acc[0], acc[1]); o.y = pk2(acc[2], acc[3]);
                *(GAS v2u*)(U.KV + (size_t)(((((eb * 8 + w) * 4 + 2 * t + (fq >> 1)) * 16 + fr) * 8) + 4 * (fq & 1))) = o; } }
    }
}
__device__ __forceinline__ void ret_unit_a2(const Args& A, LAS unsigned char* lds, int bh, int c, int tid) {
    const RetA U0 = ret_a_setup(A, lds, bh, c, 0), U1 = ret_a_setup(A, lds, bh, c + 1, 1);
    ret_a_scores(U0, tid); ret_a_scores(U1, tid);
    __syncthreads();
    ret_a_rest(U0, tid); ret_a_rest(U1, tid);
    __syncthreads();
}
__device__ __forceinline__ void ret_scan_b(const Args& A, int gi, int ng, int tid) {
    bf16* KV = (bf16*)A.out;
    for (int it = gi * NTHR + tid; it < 8 * 8192; it += ng * NTHR) { const int bh = it >> 13, vec = it & 8191; const float cd = exp2f(ret_log2g(bh & 3) * 64.0f);
        bf16* p = KV + (size_t)bh * 64 * 65536 + vec * 8; float sx[8];
#pragma unroll
        for (int i = 0; i < 8; ++i) sx[i] = 0.f;
#pragma unroll 1
        for (int c0 = 0; c0 < 64; c0 += 32) { v4u kv[32];
#pragma unroll
            for (int j = 0; j < 32; ++j) kv[j] = *(const GAS v4u*)(p + (size_t)(c0 + j) * 65536);
#pragma unroll
            for (int j = 0; j < 32; ++j) { v4u o; o.x = pk2(sx[0], sx[1]); o.y = pk2(sx[2], sx[3]); o.z = pk2(sx[4], sx[5]); o.w = pk2(sx[6], sx[7]);
                *(GAS v4u*)(p + (size_t)(c0 + j) * 65536) = o;
                sx[0] = sx[0] * cd + bflo(kv[j].x); sx[1] = sx[1] * cd + bfhi(kv[j].x); sx[2] = sx[2] * cd + bflo(kv[j].y); sx[3] = sx[3] * cd + bfhi(kv[j].y);
                sx[4] = sx[4] * cd + bflo(kv[j].z); sx[5] = sx[5] * cd + bfhi(kv[j].z); sx[6] = sx[6] * cd + bflo(kv[j].w); sx[7] = sx[7] * cd + bfhi(kv[j].w); } } }
}
__device__ __forceinline__ void ret_unit_c(const Args& A, int bh, int c, int tid) {
    unsigned char* ws = A.ws;
    const int lane = tid & 63, w = tid >> 6, fr = lane & 15, fq = lane >> 4, b = bh >> 2, h = bh & 3;
    const float l2g = ret_log2g(h);
    const size_t tok0 = (size_t)b * SEQ + c * 64;
    const bf16* Qc = (const bf16*)(ws + WS_QB) + tok0 * 1024 + h * 256;
    const bf16* Sc = (const bf16*)A.out + (size_t)(bh * 64 + c) * 65536;
    bf16* Oret = (bf16*)(ws + WS_ORET);
    f32x4 acc[2][4];
#pragma unroll
    for (int t = 0; t < 2; ++t)
#pragma unroll
        for (int nb = 0; nb < 4; ++nb) acc[t][nb] = (f32x4){0.f, 0.f, 0.f, 0.f};
#pragma unroll
    for (int ks = 0; ks < 8; ++ks) { bf16x8 sf[2], qf[4];
#pragma unroll
        for (int t = 0; t < 2; ++t) sf[t] = *(const GAS bf16x8*)(Sc + (size_t)(((((2 * w + t) * 8 + ks) * 4 + fq) * 16 + fr) * 8));
#pragma unroll
        for (int nb = 0; nb < 4; ++nb) qf[nb] = *(const GAS bf16x8*)(Qc + (size_t)(nb * 16 + fr) * 1024 + ks * 32 + fq * 8);
#pragma unroll
        for (int t = 0; t < 2; ++t)
#pragma unroll
            for (int nb = 0; nb < 4; ++nb) acc[t][nb] = mfma16(sf[t], qf[nb], acc[t][nb]); }
#pragma unroll
    for (int nb = 0; nb < 4; ++nb) { const float qd = exp2f(l2g * (float)(nb * 16 + fr + 1));
#pragma unroll
        for (int t = 0; t < 2; ++t) { bf16* op = Oret + (tok0 + nb * 16 + fr) * 1024 + h * 256 + (2 * w + t) * 16 + 4 * fq;
            const v2u o0 = *(const GAS v2u*)op; v2u o;
            o.x = pk2(bflo(o0.x) + qd * acc[t][nb][0], bfhi(o0.x) + qd * acc[t][nb][1]); o.y = pk2(bflo(o0.y) + qd * acc[t][nb][2], bfhi(o0.y) + qd * acc[t][nb][3]);
            *(GAS v2u*)op = o; } }
}

constexpr int RTS = 32;
__device__ __forceinline__ void rwkv_scan_unit(const Args& A, LAS unsigned char* lds, int bh, int rq, int cvt_unit, int cvt_n, int tid) {
    unsigned char* ws = A.ws;
    const int b = bh >> 4, h = bh & 15, lane = tid & 63;
    const bf16* RKV = (const bf16*)(ws + WS_RKV); const bf16* Ab = (const bf16*)(ws + WS_AB); const float* DEC = (const float*)(ws + WS_DEC); float* Y = (float*)(ws + WS_Y);
    const int lt = tid & 255, ts = lt >> 4, jq = lt & 15, j0 = 4 * jq;
    const int irow = rq * 16 + ((tid >> 4) & 15), jj = tid & 15;
    const bool scanner = tid < 256;
    const f32x4 kkw = *(const GAS f32x4*)(A.in[11] + h * 64 + j0), kaw = *(const GAS f32x4*)(A.in[12] + h * 64 + j0);
    auto sbuf = [&](int b2, int arr) -> LAS float* { return (LAS float*)(lds + b2 * 49152 + arr * 8192); };
    v2u lr[2], lk[2], lv[2], la[2]; f32x4 lw[2];
    auto issue = [&](int st) {
#pragma unroll
        for (int u = 0; u < 2; ++u) { const size_t n = (size_t)b * SEQ + st * RTS + ts + 16 * u;
            lr[u] = *(const GAS v2u*)(RKV + n * 3072 + h * 64 + j0); lk[u] = *(const GAS v2u*)(RKV + n * 3072 + 1024 + h * 64 + j0); lv[u] = *(const GAS v2u*)(RKV + n * 3072 + 2048 + h * 64 + j0);
            la[u] = *(const GAS v2u*)(Ab + n * 1024 + h * 64 + j0); lw[u] = *(const GAS f32x4*)(DEC + n * 1024 + h * 64 + j0); } };
    auto commit = [&](int b2) {
#pragma unroll
        for (int u = 0; u < 2; ++u) { const int t2 = ts + 16 * u;
            const f32x4 k = {bflo(lk[u].x), bfhi(lk[u].x), bflo(lk[u].y), bfhi(lk[u].y)}, a = {bflo(la[u].x), bfhi(la[u].x), bflo(la[u].y), bfhi(la[u].y)};
            const f32x4 r = {bflo(lr[u].x), bfhi(lr[u].x), bflo(lr[u].y), bfhi(lr[u].y)}, v = {bflo(lv[u].x), bfhi(lv[u].x), bflo(lv[u].y), bfhi(lv[u].y)};
            f32x4 kk = k * kkw; float ss = (kk.x * kk.x + kk.y * kk.y) + (kk.z * kk.z + kk.w * kk.w); ss = rowsum16(ss);
            const float inv = 1.0f / fmaxf(sqrtf(ss), 1e-12f); kk = kk * inv;
            const f32x4 kka = kk * a, kp = k * (1.0f + (a - 1.0f) * kaw);
            *(LAS f32x4*)(sbuf(b2, 0) + t2 * 64 + j0) = kk; *(LAS f32x4*)(sbuf(b2, 1) + t2 * 64 + j0) = kka; *(LAS f32x4*)(sbuf(b2, 2) + t2 * 64 + j0) = lw[u];
            *(LAS f32x4*)(sbuf(b2, 3) + t2 * 64 + j0) = kp; *(LAS f32x4*)(sbuf(b2, 4) + t2 * 64 + j0) = r; *(LAS f32x4*)(sbuf(b2, 5) + t2 * 64 + j0) = v; } };
    const int cw = cvt_unit * 4 + ((tid >> 6) & 3), cstride = 4 * cvt_n; int crow = cw; float cx[32];
    auto cvt_load = [&]() { if (crow < 2 * 16384) { const float* src = A.in[23 + (crow >> 14)] + (size_t)(crow & 16383) * DM;
#pragma unroll
            for (int j = 0; j < 2; ++j)
#pragma unroll
                for (int q = 0; q < 4; ++q) { const f32x4 t = *(const GAS f32x4*)(src + j * 1024 + lane * 16 + q * 4); cx[j * 16 + q * 4] = t.x; cx[j * 16 + q * 4 + 1] = t.y; cx[j * 16 + q * 4 + 2] = t.z; cx[j * 16 + q * 4 + 3] = t.w; } } };
    auto cvt_store = [&]() { if (crow < 2 * 16384) { const int which = crow >> 14, e = crow & 16383; float am = 0.f;
#pragma unroll
            for (int i = 0; i < 32; ++i) am += cx[i] * cx[i];
            am = wave_sum(am); const float dl = 0.3352f * sqrtf(am * (1.0f / 2048.0f)); const float inv = am > 0.f ? 1.0f / dl : 0.f, sc = am > 0.f ? dl : 1.0f;
            unsigned char* dst = ws + (which ? WS_V8 : WS_U8) + (size_t)e * 1024;
            v4u o;
#pragma unroll
            for (int k = 0; k < 4; ++k) { unsigned w = 0;
#pragma unroll
                for (int n = 0; n < 8; ++n) { int v = (int)floorf(cx[k * 8 + n] * inv); v = v < -8 ? -8 : (v > 7 ? 7 : v); w |= ((unsigned)v & 0xfu) << (4 * n); }
                o[k] = which ? (w ^ 0x08080808u) : w; }
            *(GAS v4u*)(dst + lane * 16) = o;
            if (lane == 0) ((float*)(ws + (which ? WS_SCV : WS_SCU)))[e] = sc; crow += cstride; } };
    if (!scanner) { issue(0); commit(0); }
    __syncthreads();
    f32x4 S = {0.f, 0.f, 0.f, 0.f};
    constexpr int NST = SEQ / RTS;
    for (int st = 0; st < NST; ++st) { const int b2 = st & 1;
        if (scanner) {
        const LAS float* KK = sbuf(b2, 0) + 4 * jj; const LAS float* KKA = sbuf(b2, 1) + 4 * jj; const LAS float* W = sbuf(b2, 2) + 4 * jj; const LAS float* KP = sbuf(b2, 3) + 4 * jj; const LAS float* R = sbuf(b2, 4) + 4 * jj; const LAS float* V = sbuf(b2, 5) + irow;
        f32x4 nkk = *(const LAS f32x4*)KK, nkka = *(const LAS f32x4*)KKA, nw = *(const LAS f32x4*)W, nkp = *(const LAS f32x4*)KP, nr = *(const LAS f32x4*)R; float nv = V[0];
#pragma unroll
        for (int q = 0; q < RTS / 16; ++q) { float ysel = 0.f, yp = 0.f;
#pragma unroll
            for (int s16 = 0; s16 < 16; ++s16) { const int s = q * 16 + s16;
                const f32x4 kk = nkk, kka = nkka, wv = nw, kp = nkp, rr = nr; const float vi = nv;
                if (s + 1 < RTS) { nkk = *(const LAS f32x4*)(KK + (s + 1) * 64); nkka = *(const LAS f32x4*)(KKA + (s + 1) * 64); nw = *(const LAS f32x4*)(W + (s + 1) * 64); nkp = *(const LAS f32x4*)(KP + (s + 1) * 64); nr = *(const LAS f32x4*)(R + (s + 1) * 64); nv = V[(s + 1) * 64]; }
                float p = __builtin_fmaf(S.w, kk.w, __builtin_fmaf(S.z, kk.z, __builtin_fmaf(S.y, kk.y, S.x * kk.x)));
                const f32x4 t = kp * vi;
                if (s16 > 0) {
                    p += dppf<0x128>(p); yp += dppf<0x128>(yp); p += dppf<0x124>(p); yp += dppf<0x124>(yp);
                    p += dppf<0x122>(p); yp += dppf<0x122>(yp); p += dppf<0x121>(p); yp += dppf<0x121>(yp);
                    ysel = (s16 - 1 == jj) ? yp : ysel;
                } else p = rowsum16(p);
                S = S * wv + (t - kka * p);
                yp = __builtin_fmaf(S.w, rr.w, __builtin_fmaf(S.z, rr.z, __builtin_fmaf(S.y, rr.y, S.x * rr.x))); }
            yp = rowsum16(yp); ysel = (jj == 15) ? yp : ysel;
            Y[((size_t)b * SEQ + st * RTS + q * 16 + jj) * 1024 + h * 64 + irow] = ysel; }
        } else {
            if (st + 1 < NST) { issue(st + 1); commit(b2 ^ 1); }
            if (st & 1) cvt_store(); else cvt_load();
        }
        __syncthreads();
    }
    if (!scanner) {
        if (NST & 1) cvt_store();
        while (crow < 2 * 16384) { cvt_load(); cvt_store(); } }
}
__device__ __forceinline__ void experts_convert(const Args& A, int bi, int nb, int tid) {
    unsigned char* ws = A.ws; const int lane = tid & 63, gw = bi * NWAVES + (tid >> 6), NGW = nb * NWAVES;
    for (int row = gw; row < 2 * 16384; row += NGW) { const int which = row >> 14, e = row & 16383;
        const float* src = A.in[23 + which] + (size_t)e * DM; float x[32];
#pragma unroll
        for (int j = 0; j < 2; ++j)
#pragma unroll
            for (int q = 0; q < 4; ++q) { const f32x4 t = *(const GAS f32x4*)(src + j * 1024 + lane * 16 + q * 4); x[j * 16 + q * 4] = t.x; x[j * 16 + q * 4 + 1] = t.y; x[j * 16 + q * 4 + 2] = t.z; x[j * 16 + q * 4 + 3] = t.w; }
        float am = 0.f;
#pragma unroll
        for (int i = 0; i < 32; ++i) am = fmaxf(am, fabsf(x[i]));
        am = wave_max(am); const float inv = am > 0.f ? 127.0f / am : 0.f, sc = am > 0.f ? am * (1.0f / 127.0f) : 1.0f;
        unsigned char* dst = ws + (which ? WS_V8 : WS_U8) + (size_t)e * DM;
#pragma unroll
        for (int j = 0; j < 2; ++j) { v4u o;
#pragma unroll
            for (int q = 0; q < 4; ++q) { unsigned w = 0;
#pragma unroll
                for (int bq = 0; bq < 4; ++bq) { int v = (int)rintf(x[j * 16 + q * 4 + bq] * inv); v = v < -127 ? -127 : (v > 127 ? 127 : v); w |= ((unsigned)v & 0xffu) << (8 * bq); }
                o[q] = w; }
            *(GAS v4u*)(dst + j * 1024 + lane * 16) = o; }
        if (lane == 0) ((float*)(ws + (which ? WS_SCV : WS_SCU)))[e] = sc; }
}

__device__ __forceinline__ void p4_post(const Args& A, int vcu, int G, int tid) {
    const int lane = tid & 63, wave = tid >> 6; unsigned char* ws = A.ws;
    const int gw = vcu * NWAVES + wave, NGW = G * NWAVES;
    const bf16* Oret = (const bf16*)(ws + WS_ORET); const bf16* Gb = (const bf16*)(ws + WS_GB); unsigned char* ORN = ws + WS_ORN; unsigned char* OWN = ws + WS_OWN; float* SAR = (float*)(ws + WS_SAR); float* SAW = (float*)(ws + WS_SAW);
    const float* Y = (const float*)(ws + WS_Y); const bf16* RKV = (const bf16*)(ws + WS_RKV); const bf16* Ab = (const bf16*)(ws + WS_AB); const bf16* Gg = (const bf16*)(ws + WS_GG);
    for (int n = gw; n < NTOK; n += NGW) {
        {
            const int c0 = (lane >> 4) * 256 + (lane & 15) * 16; float x[16], g[16];
            { const v4u a = *(const GAS v4u*)(Oret + (size_t)n * 1024 + c0), c = *(const GAS v4u*)(Oret + (size_t)n * 1024 + c0 + 8);
              x[0] = bflo(a.x); x[1] = bfhi(a.x); x[2] = bflo(a.y); x[3] = bfhi(a.y); x[4] = bflo(a.z); x[5] = bfhi(a.z); x[6] = bflo(a.w); x[7] = bfhi(a.w);
              x[8] = bflo(c.x); x[9] = bfhi(c.x); x[10] = bflo(c.y); x[11] = bfhi(c.y); x[12] = bflo(c.z); x[13] = bfhi(c.z); x[14] = bflo(c.w); x[15] = bfhi(c.w); }
            { const v4u a = *(const GAS v4u*)(Gb + (size_t)n * 1024 + c0), c = *(const GAS v4u*)(Gb + (size_t)n * 1024 + c0 + 8);
              g[0] = bflo(a.x); g[1] = bfhi(a.x); g[2] = bflo(a.y); g[3] = bfhi(a.y); g[4] = bflo(a.z); g[5] = bfhi(a.z); g[6] = bflo(a.w); g[7] = bfhi(a.w);
              g[8] = bflo(c.x); g[9] = bfhi(c.x); g[10] = bflo(c.y); g[11] = bfhi(c.y); g[12] = bflo(c.z); g[13] = bfhi(c.z); g[14] = bflo(c.w); g[15] = bfhi(c.w); }
            float s = 0.f;
#pragma unroll
            for (int i = 0; i < 16; ++i) s += x[i];
            const float mu = rowsum16(s) * (1.f / 256.f); float q = 0.f;
#pragma unroll
            for (int i = 0; i < 16; ++i) { x[i] -= mu; q += x[i] * x[i]; }
            const float rstd = 1.0f / sqrtf(rowsum16(q) * (1.f / 256.f) + 1e-6f);
            const float* gw_ = A.in[3] + c0; const float* gb_ = A.in[4] + c0; float am = 0.f;
#pragma unroll
            for (int i = 0; i < 16; ++i) { x[i] = (x[i] * rstd * gw_[i] + gb_[i]) * g[i]; am = fmaxf(am, fabsf(x[i])); }
            am = fmaxf(wave_max(am), 1e-30f); const float inv = 127.0f / am; v4u o;
#pragma unroll
            for (int i = 0; i < 4; ++i) o[i] = ((unsigned)(int)rintf(x[4 * i] * inv) & 0xffu) | (((unsigned)(int)rintf(x[4 * i + 1] * inv) & 0xffu) << 8) | (((unsigned)(int)rintf(x[4 * i + 2] * inv) & 0xffu) << 16) | (((unsigned)(int)rintf(x[4 * i + 3] * inv) & 0xffu) << 24);
            *(GAS v4u*)(ORN + (size_t)n * 1024 + c0) = o; if (lane == 0) SAR[n] = am * (1.0f / 127.0f);
        }
        {
            const int c0 = (lane >> 2) * 64 + (lane & 3) * 16; float y[16], r[16], k[16], v[16], a[16], g[16];
#pragma unroll
            for (int i = 0; i < 4; ++i) { const f32x4 t = *(const GAS f32x4*)(Y + (size_t)n * 1024 + c0 + 4 * i); y[4 * i] = t.x; y[4 * i + 1] = t.y; y[4 * i + 2] = t.z; y[4 * i + 3] = t.w; }
#define LD16(dst, ptr) do { const v4u a_ = *(const GAS v4u*)(ptr), c_ = *(const GAS v4u*)((ptr) + 8); \
            dst[0] = bflo(a_.x); dst[1] = bfhi(a_.x); dst[2] = bflo(a_.y); dst[3] = bfhi(a_.y); dst[4] = bflo(a_.z); dst[5] = bfhi(a_.z); dst[6] = bflo(a_.w); dst[7] = bfhi(a_.w); \
            dst[8] = bflo(c_.x); dst[9] = bfhi(c_.x); dst[10] = bflo(c_.y); dst[11] = bfhi(c_.y); dst[12] = bflo(c_.z); dst[13] = bfhi(c_.z); dst[14] = bflo(c_.w); dst[15] = bfhi(c_.w); } while (0)
            LD16(r, RKV + (size_t)n * 3072 + c0); LD16(k, RKV + (size_t)n * 3072 + 1024 + c0); LD16(v, RKV + (size_t)n * 3072 + 2048 + c0);
            LD16(a, Ab + (size_t)n * 1024 + c0); LD16(g, Gg + (size_t)n * 1024 + c0);
#undef LD16
            float s = 0.f;
#pragma unroll
            for (int i = 0; i < 16; ++i) s += y[i];
            const float mu = quadsum(s) * (1.f / 64.f); float q = 0.f;
#pragma unroll
            for (int i = 0; i < 16; ++i) { y[i] -= mu; q += y[i] * y[i]; }
            const float rstd = 1.0f / sqrtf(quadsum(q) * (1.f / 64.f) + 64e-5f);
            const float* ka = A.in[12] + c0; const float* rk = A.in[13] + c0; const float* lw = A.in[14] + c0; const float* lb = A.in[15] + c0;
            float bs = 0.f;
#pragma unroll
            for (int i = 0; i < 16; ++i) { const float kp = k[i] * (1.0f + (a[i] - 1.0f) * ka[i]); bs += r[i] * kp * rk[i]; }
            bs = quadsum(bs); float am = 0.f;
#pragma unroll
            for (int i = 0; i < 16; ++i) { y[i] = (y[i] * rstd * lw[i] + lb[i] + bs * v[i]) * g[i]; am = fmaxf(am, fabsf(y[i])); }
            am = fmaxf(wave_max(am), 1e-30f); const float inv = 127.0f / am; v4u o;
#pragma unroll
            for (int i = 0; i < 4; ++i) o[i] = ((unsigned)(int)rintf(y[4 * i] * inv) & 0xffu) | (((unsigned)(int)rintf(y[4 * i + 1] * inv) & 0xffu) << 8) | (((unsigned)(int)rintf(y[4 * i + 2] * inv) & 0xffu) << 16) | (((unsigned)(int)rintf(y[4 * i + 3] * inv) & 0xffu) << 24);
            *(GAS v4u*)(OWN + (size_t)n * 1024 + c0) = o; if (lane == 0) SAW[n] = am * (1.0f / 127.0f);
        }
    }
}

__device__ __forceinline__ float ub0(unsigned w) { return (float)(w & 0xffu); }
__device__ __forceinline__ float ub1(unsigned w) { return (float)((w >> 8) & 0xffu); }
__device__ __forceinline__ float ub2(unsigned w) { return (float)((w >> 16) & 0xffu); }
__device__ __forceinline__ float ub3(unsigned w) { return (float)(w >> 24); }
__device__ __forceinline__ float dpp_max_bcast15(float m) { const int b = __builtin_bit_cast(int, m); return fmaxf(m, __builtin_bit_cast(float, __builtin_amdgcn_update_dpp(b, b, 0x142, 0xa, 0xf, false))); }
__device__ __forceinline__ float dpp_max_bcast31(float m) { const int b = __builtin_bit_cast(int, m); return fmaxf(m, __builtin_bit_cast(float, __builtin_amdgcn_update_dpp(b, b, 0x143, 0xc, 0xf, false))); }
__device__ __forceinline__ float rdlane_f(float v, int l) { return __builtin_bit_cast(float, __builtin_amdgcn_readlane(__builtin_bit_cast(int, v), l)); }
__device__ __forceinline__ unsigned ord_key(float f) { const unsigned u = __builtin_bit_cast(unsigned, f); return (u & 0x80000000u) ? ~u : (u | 0x80000000u); }
__device__ __forceinline__ float ord_val(unsigned k) { const unsigned u = (k & 0x80000000u) ? (k & 0x7fffffffu) : ~k; return __builtin_bit_cast(float, u); }
__device__ __forceinline__ void peer_topk_radix_v(const float (&scv)[4], LAS float* wsc, int lane, int& expert, float& gate) {
    const int half = lane >> 5, l32 = lane & 31;
    unsigned key[4];
#pragma unroll
    for (int q = 0; q < 4; ++q) key[q] = (ord_key(scv[q]) & ~0x7fu) | (unsigned)(l32 + 32 * q);
    unsigned Pl = 0xBF800000u, Ph = 0xBF800000u; bool done = false;
    { int cl, ch;
#define PEER_CNT(tl_, th_) do { const unsigned trial_ = half ? (th_) : (tl_); \
        const unsigned long long m0 = __ballot(key[0] >= trial_), m1 = __ballot(key[1] >= trial_), m2 = __ballot(key[2] >= trial_), m3 = __ballot(key[3] >= trial_); \
        cl = __builtin_popcount((unsigned)m0) + __builtin_popcount((unsigned)m1) + __builtin_popcount((unsigned)m2) + __builtin_popcount((unsigned)m3); \
        ch = __builtin_popcount((unsigned)(m0 >> 32)) + __builtin_popcount((unsigned)(m1 >> 32)) + __builtin_popcount((unsigned)(m2 >> 32)) + __builtin_popcount((unsigned)(m3 >> 32)); } while (0)
      PEER_CNT(Pl, Ph);
      const bool upL = cl >= 16, upH = ch >= 16; bool doneL = false, doneH = false;
#pragma unroll 1
      for (int it = 0; it < 600 && !(doneL && doneH); ++it) { const unsigned tl = doneL ? Pl : (upL ? Pl + 0x800000u : Pl - 0x800000u), th = doneH ? Ph : (upH ? Ph + 0x800000u : Ph - 0x800000u);
          PEER_CNT(tl, th);
          if (!doneL) { if (upL) { if (cl >= 16) Pl = tl; else doneL = true; } else { Pl = tl; if (cl >= 16) doneL = true; } }
          if (!doneH) { if (upH) { if (ch >= 16) Ph = th; else doneH = true; } else { Ph = th; if (ch >= 16) doneH = true; } } }
    }
    unsigned K = half ? Ph : Pl;
    int cntL = 999, cntH = 999;
#pragma unroll 1
    for (int b = 22; b >= 0 && !done; --b) { const unsigned trial = K | (1u << b); int cl, ch;
        PEER_CNT(trial, trial);
        const bool al = cl >= 16, ah = ch >= 16;
        K = (half ? ah : al) ? trial : K;
        if (al) cntL = cl; if (ah) cntH = ch;
        if (cntL == 16 && cntH == 16) done = true; }
#undef PEER_CNT
    int base = 0;
#pragma unroll
    for (int q = 0; q < 4; ++q) { const bool sel = key[q] >= K; const unsigned long long m = __ballot(sel);
        const unsigned ml = (unsigned)m, mh = (unsigned)(m >> 32);
        const int below = half ? (int)__builtin_amdgcn_mbcnt_hi(mh, 0u) : (int)__builtin_amdgcn_mbcnt_lo(ml, 0u);
        const int p = base + below;
        if (sel) { wsc[half * 32 + p] = ord_val(key[q] & ~0x7fu); wsc[half * 32 + 16 + p] = __int_as_float((int)(key[q] & 0x7fu)); }
        base += __builtin_popcount(half ? mh : ml); }
    LDS_WAIT(); asm volatile("" ::: "memory");
    const int a = lane >> 2, b0 = 4 * (lane & 3);
    const float va = wsc[a]; unsigned ck[4];
#pragma unroll
    for (int q = 0; q < 4; ++q) ck[q] = (ord_key(va + wsc[32 + b0 + q]) & ~0xffu) | (unsigned)(a * 16 + b0 + q);
    unsigned K2 = 0xC0800000u;
    {
#define PEER_CNT2(t_) (__builtin_popcountll(__ballot(ck[0] >= (t_))) + __builtin_popcountll(__ballot(ck[1] >= (t_))) + __builtin_popcountll(__ballot(ck[2] >= (t_))) + __builtin_popcountll(__ballot(ck[3] >= (t_))))
      const bool up = PEER_CNT2(K2) >= 16; bool dn = false;
#pragma unroll 1
      for (int it = 0; it < 600 && !dn; ++it) { const unsigned t = up ? K2 + 0x800000u : K2 - 0x800000u; const int c = PEER_CNT2(t);
          if (up) { if (c >= 16) K2 = t; else dn = true; } else { K2 = t; if (c >= 16) dn = true; } }
#pragma unroll 1
      for (int b = 22; b >= 0; --b) { const unsigned trial = K2 | (1u << b); const int c = PEER_CNT2(trial);
          if (c >= 16) { K2 = trial; if (c == 16) break; } }
#undef PEER_CNT2
    }
    const int e1a = __float_as_int(wsc[16 + a]); int base2 = 0;
#pragma unroll
    for (int q = 0; q < 4; ++q) { const bool sel = ck[q] >= K2; const unsigned long long m = __ballot(sel);
        const int p = base2 + (int)__builtin_amdgcn_mbcnt_hi((unsigned)(m >> 32), __builtin_amdgcn_mbcnt_lo((unsigned)m, 0u));
        if (sel) { wsc[64 + p] = ord_val(ck[q] & ~0xffu); wsc[80 + p] = __int_as_float(e1a * 128 + __float_as_int(wsc[48 + b0 + q])); }
        base2 += (int)__builtin_popcountll(m); }
    LDS_WAIT(); asm volatile("" ::: "memory");
    const float gv = lane < 16 ? wsc[64 + lane] : -3.0e38f; expert = lane < 16 ? (__float_as_int(wsc[80 + lane]) & 16383) : 0;
    const float top = rowmax16(gv); const float e = lane < 16 ? __expf(gv - top) : 0.f; const float se = fmaxf(rowsum16(e), 1e-30f); gate = e / se;
    LDS_WAIT(); asm volatile("" ::: "memory");
}
__device__ __forceinline__ unsigned sel_u(unsigned a, unsigned b, int take) { return a ^ ((a ^ b) & (unsigned)(-take)); }
__device__ __forceinline__ void peer_topk_radix_w(const float (&s1)[2], const float (&s2)[2], LAS float* wsc, int lane, int& expert, float& gate) {
    unsigned k1[2], k2[2];
#pragma unroll
    for (int q = 0; q < 2; ++q) { k1[q] = (ord_key(s1[q]) & ~0x7fu) | (unsigned)(lane + 64 * q); k2[q] = (ord_key(s2[q]) & ~0x7fu) | (unsigned)(lane + 64 * q); }
#define PEER_C1(t_) ((int)__builtin_popcountll(__ballot(k1[0] >= (t_))) + (int)__builtin_popcountll(__ballot(k1[1] >= (t_))))
#define PEER_C2(t_) ((int)__builtin_popcountll(__ballot(k2[0] >= (t_))) + (int)__builtin_popcountll(__ballot(k2[1] >= (t_))))
    unsigned K1 = 0xBF800000u; int c1 = PEER_C1(K1);
    if (c1 >= 16) { for (;;) { const int n = PEER_C1(K1 + 0x800000u); if (n < 16) break; K1 += 0x800000u; c1 = n; } }
    else { do { K1 -= 0x800000u; c1 = PEER_C1(K1); } while (c1 < 16); }
#pragma unroll 1
    for (unsigned bit = 1u << 22; bit != 0u && c1 != 16; bit >>= 1) { const int n = PEER_C1(K1 | bit); if (n >= 16) { K1 |= bit; c1 = n; } }
    unsigned K2 = 0xBF800000u; int c2 = PEER_C2(K2);
    if (c2 >= 16) { for (;;) { const int n = PEER_C2(K2 + 0x800000u); if (n < 16) break; K2 += 0x800000u; c2 = n; } }
    else { do { K2 -= 0x800000u; c2 = PEER_C2(K2); } while (c2 < 16); }
#pragma unroll 1
    for (unsigned bit = 1u << 22; bit != 0u && c2 != 16; bit >>= 1) { const int n = PEER_C2(K2 | bit); if (n >= 16) { K2 |= bit; c2 = n; } }
#undef PEER_C1
#undef PEER_C2
    { int base = 0;
#pragma unroll
      for (int q = 0; q < 2; ++q) { const bool sel = k1[q] >= K1; const unsigned long long m = __ballot(sel);
          const int p = base + (int)__builtin_amdgcn_mbcnt_hi((unsigned)(m >> 32), __builtin_amdgcn_mbcnt_lo((unsigned)m, 0u));
          if (sel) { wsc[p] = ord_val(k1[q] & ~0x7fu); wsc[16 + p] = __int_as_float((int)(k1[q] & 0x7fu)); }
          base += (int)__builtin_popcountll(m); }
      base = 0;
#pragma unroll
      for (int q = 0; q < 2; ++q) { const bool sel = k2[q] >= K2; const unsigned long long m = __ballot(sel);
          const int p = base + (int)__builtin_amdgcn_mbcnt_hi((unsigned)(m >> 32), __builtin_amdgcn_mbcnt_lo((unsigned)m, 0u));
          if (sel) { wsc[32 + p] = ord_val(k2[q] & ~0x7fu); wsc[48 + p] = __int_as_float((int)(k2[q] & 0x7fu)); }
          base += (int)__builtin_popcountll(m); } }
    LDS_WAIT(); asm volatile("" ::: "memory");
    const int a = lane >> 2, b0 = 4 * (lane & 3);
    const float va = wsc[a]; unsigned ck[4];
#pragma unroll
    for (int q = 0; q < 4; ++q) ck[q] = (ord_key(va + wsc[32 + b0 + q]) & ~0xffu) | (unsigned)(a * 16 + b0 + q);
    unsigned K3 = 0xC0800000u; int c3;
    {
#define PEER_C3(t_) ((int)__builtin_popcountll(__ballot(ck[0] >= (t_))) + (int)__builtin_popcountll(__ballot(ck[1] >= (t_))) + (int)__builtin_popcountll(__ballot(ck[2] >= (t_))) + (int)__builtin_popcountll(__ballot(ck[3] >= (t_))))
      c3 = PEER_C3(K3);
      if (c3 >= 16) { for (;;) { const int n = PEER_C3(K3 + 0x800000u); if (n < 16) break; K3 += 0x800000u; c3 = n; } }
      else { do { K3 -= 0x800000u; c3 = PEER_C3(K3); } while (c3 < 16); }
#pragma unroll 1
      for (unsigned bit = 1u << 22; bit != 0u && c3 != 16; bit >>= 1) { const int n = PEER_C3(K3 | bit); if (n >= 16) { K3 |= bit; c3 = n; } }
#undef PEER_C3
    }
    const int e1a = __float_as_int(wsc[16 + a]); int base2 = 0;
#pragma unroll
    for (int q = 0; q < 4; ++q) { const bool sel = ck[q] >= K3; const unsigned long long m = __ballot(sel);
        const int p = base2 + (int)__builtin_amdgcn_mbcnt_hi((unsigned)(m >> 32), __builtin_amdgcn_mbcnt_lo((unsigned)m, 0u));
        if (sel) { wsc[64 + p] = ord_val(ck[q] & ~0xffu); wsc[80 + p] = __int_as_float(e1a * 128 + __float_as_int(wsc[48 + b0 + q])); }
        base2 += (int)__builtin_popcountll(m); }
    LDS_WAIT(); asm volatile("" ::: "memory");
    const float gv = lane < 16 ? wsc[64 + lane] : -3.0e38f; expert = lane < 16 ? (__float_as_int(wsc[80 + lane]) & 16383) : 0;
    const float top = rowmax16(gv); const float e = lane < 16 ? __expf(gv - top) : 0.f; const float se = fmaxf(rowsum16(e), 1e-30f); gate = e / se;
    LDS_WAIT(); asm volatile("" ::: "memory");
}
__device__ __forceinline__ void peer_topk_radix(const float* sc256, LAS float* wsc, int lane, int& expert, float& gate) {
    const float* sc = sc256 + (lane >> 5) * 128 + (lane & 31); const float scv[4] = {sc[0], sc[32], sc[64], sc[96]}; peer_topk_radix_v(scv, wsc, lane, expert, gate); }
__device__ __forceinline__ void peer_phase(const Args& A, LAS unsigned char* lds, int vcu, int G, int tid) {
    unsigned char* ws = A.ws;
    const int lane = tid & 63, hh = tid >> 6;
    const float* SC = (const float*)(ws + WS_SC); const bf16* H2 = (const bf16*)(ws + WS_H2); const unsigned char* U8 = ws + WS_U8; const unsigned char* V8 = ws + WS_V8;
    const float* SCU = (const float*)(ws + WS_SCU); const float* SCV = (const float*)(ws + WS_SCV);
    LAS float* red = (LAS float*)lds;
    LAS float* wsc = (LAS float*)(lds + 65536 + hh * 512);
    LAS float* bred = (LAS float*)(lds + 65536 + 4096);
    int ca = 0, cb = 0; bool cvalid = false;
    { int base = 0;
#pragma unroll
      for (int a = 0; a < 16; ++a) { const int cnt = 16 / (a + 1); if (lane >= base && lane < base + cnt) { ca = a; cb = lane - base; cvalid = true; } base += cnt; } }
    const int half = lane >> 5, l32 = lane & 31;
#define PEER_TOPK(n_, expert_, gate_, su_, sv_) do { \
        const float* sc = SC + (size_t)((n_) * 8 + hh) * 256 + half * 128 + l32; \
        float v[4] = {sc[0], sc[32], sc[64], sc[96]}; float tv = 0.f; int ti = 0; \
        _Pragma("unroll 1") for (int k = 0; k < 16; ++k) { \
            float m = fmaxf(fmaxf(v[0], v[1]), fmaxf(v[2], v[3])); float r = rowmax16(m); r = dpp_max_bcast15(r); \
            const float wm1 = rdlane_f(r, 31), wm2 = rdlane_f(r, 63), wm = half ? wm2 : wm1; \
            const unsigned long long mask = __ballot(m == wm); \
            const int o1 = (int)__builtin_ctz((unsigned)mask), o2 = 32 + (int)__builtin_ctz((unsigned)(mask >> 32)); \
            int qi = 3; if (v[2] == wm) qi = 2; if (v[1] == wm) qi = 1; if (v[0] == wm) qi = 0; \
            const int gi = l32 + 32 * qi; const int w1 = __builtin_amdgcn_readlane(gi, o1), w2 = __builtin_amdgcn_readlane(gi, o2); \
            if (lane == o1 || lane == o2) { v[0] = qi == 0 ? -3.0e38f : v[0]; v[1] = qi == 1 ? -3.0e38f : v[1]; v[2] = qi == 2 ? -3.0e38f : v[2]; v[3] = qi == 3 ? -3.0e38f : v[3]; } \
            if (l32 == k) { tv = wm; ti = half ? w2 : w1; } } \
        if (l32 < 16) { wsc[half * 32 + l32] = tv; wsc[half * 32 + 16 + l32] = __int_as_float(ti); } \
        LDS_WAIT(); asm volatile("" ::: "memory"); \
        float cs = cvalid ? wsc[ca] + wsc[32 + cb] : -3.0e38f; float gv = 0.f; int gc = 0; \
        _Pragma("unroll 1") for (int k = 0; k < 16; ++k) { \
            float r = rowmax16(cs); r = dpp_max_bcast15(r); r = dpp_max_bcast31(r); const float wm = rdlane_f(r, 63); \
            const int o = (int)__builtin_ctzll(__ballot(cs == wm)); if (lane == o) cs = -3.0e38f; if (lane == k) { gv = wm; gc = o; } } \
        const int sa_ = __builtin_amdgcn_ds_bpermute(4 * gc, ca), sb_ = __builtin_amdgcn_ds_bpermute(4 * gc, cb); \
        { const int a_ = lane < 16 ? sa_ : 0, b_ = lane < 16 ? sb_ : 0; const int e1 = __float_as_int(wsc[16 + a_]), e2 = __float_as_int(wsc[48 + b_]); expert_ = (e1 * 128 + e2) & 16383; \
          const float top0 = rdlane_f(gv, 0); const float e = (lane < 16) ? __expf(gv - top0) : 0.f; const float se = fmaxf(rowsum16(e), 1e-30f); gate_ = e / se; } \
        LDS_WAIT(); asm volatile("" ::: "memory"); \
        su_ = SCU[expert_]; sv_ = SCV[expert_]; } while (0)
#define PEER_LOADB(dst, TAB, expert_, kb) do { _Pragma("unroll") for (int i = 0; i < 8; ++i) { const int e = __builtin_amdgcn_readlane(expert_, (kb) * 8 + i); const unsigned char* rp = TAB + (size_t)e * DM + lane * 16; dst[i][0] = *(const GAS v4u*)rp; dst[i][1] = *(const GAS v4u*)(rp + 1024); } } while (0)
#define PEER_UDOT(src, kb) do { float z[8]; \
        _Pragma("unroll") for (int i = 0; i < 8; ++i) { int a0 = 0, a1 = 0; \
            _Pragma("unroll") for (int j = 0; j < 2; ++j) _Pragma("unroll") for (int q = 0; q < 4; q += 2) { a0 = __builtin_amdgcn_sdot4((int)src[i][j][q], xq8[j * 4 + q], a0, false); a1 = __builtin_amdgcn_sdot4((int)src[i][j][q + 1], xq8[j * 4 + q + 1], a1, false); } \
            z[i] = wave_sum((float)(a0 + a1)); } \
        _Pragma("unroll") for (int i = 0; i < 8; ++i) if (lane == (kb) * 8 + i) cact = gelu_erf(z[i] * su * sx) * gate * sv; } while (0)
#define PEER_VACC(src, kb) do { _Pragma("unroll") for (int g2 = 0; g2 < 2; ++g2) { const int cqg = cq4[(kb) * 2 + g2]; \
            _Pragma("unroll") for (int j = 0; j < 2; ++j) _Pragma("unroll") for (int q = 0; q < 4; ++q) { const unsigned w0 = src[g2 * 4][j][q], w1 = src[g2 * 4 + 1][j][q], w2 = src[g2 * 4 + 2][j][q], w3 = src[g2 * 4 + 3][j][q]; \
                const unsigned t01l = __builtin_amdgcn_perm(w1, w0, 0x05010400u), t01h = __builtin_amdgcn_perm(w1, w0, 0x07030602u), t23l = __builtin_amdgcn_perm(w3, w2, 0x05010400u), t23h = __builtin_amdgcn_perm(w3, w2, 0x07030602u); \
                const int xb = j * 16 + q * 4; \
                acc[xb]     = __builtin_amdgcn_sdot4((int)__builtin_amdgcn_perm(t23l, t01l, 0x05040100u), cqg, acc[xb], false); \
                acc[xb + 1] = __builtin_amdgcn_sdot4((int)__builtin_amdgcn_perm(t23l, t01l, 0x07060302u), cqg, acc[xb + 1], false); \
                acc[xb + 2] = __builtin_amdgcn_sdot4((int)__builtin_amdgcn_perm(t23h, t01h, 0x05040100u), cqg, acc[xb + 2], false); \
                acc[xb + 3] = __builtin_amdgcn_sdot4((int)__builtin_amdgcn_perm(t23h, t01h, 0x07060302u), cqg, acc[xb + 3], false); } } } while (0)
    int expert = 0; float gate = 0.f, su = 0.f, sv = 0.f;
    if (vcu < NTOK) { peer_topk_radix(SC + (size_t)(vcu * 8 + hh) * 256, wsc, lane, expert, gate); su = SCU[expert]; sv = SCV[expert]; }
    for (int n = vcu; n < NTOK; n += G) {
        v4u ra[8][2], rb[8][2];
        PEER_LOADB(ra, U8, expert, 0); PEER_LOADB(rb, U8, expert, 1);
        int xq8[8];
#pragma unroll
        for (int j = 0; j < 2; ++j) { const v4u t = *(const GAS v4u*)(ws + WS_H2Q + (size_t)n * DM + j * 1024 + lane * 16); xq8[j * 4] = (int)t.x; xq8[j * 4 + 1] = (int)t.y; xq8[j * 4 + 2] = (int)t.z; xq8[j * 4 + 3] = (int)t.w; }
        const float sx = ((const float*)(ws + WS_SX))[n];
        float cact = 0.f;
        PEER_UDOT(ra, 0);
        PEER_LOADB(ra, V8, expert, 0);
        PEER_UDOT(rb, 1);
        PEER_LOADB(rb, V8, expert, 1);
        int nexpert = 0; float ngate = 0.f, nsu = 0.f, nsv = 0.f;
        if (n + G < NTOK) { peer_topk_radix(SC + (size_t)((n + G) * 8 + hh) * 256, wsc, lane, nexpert, ngate); nsu = SCU[nexpert]; nsv = SCV[nexpert]; }
        int acc[32];
#pragma unroll
        for (int i = 0; i < 32; ++i) acc[i] = 0;
        const float cmax = fmaxf(rdlane_f(rowmax16(lane < 16 ? fabsf(cact) : 0.f), 0), 1e-30f); const float sc = cmax * (1.0f / 127.0f);
        const int cqk = (int)rintf(cact * (127.0f / cmax)) & 0xff;
        int cq4[4];
#pragma unroll
        for (int g = 0; g < 4; ++g) cq4[g] = __builtin_amdgcn_readlane(cqk, 4 * g) | (__builtin_amdgcn_readlane(cqk, 4 * g + 1) << 8) | (__builtin_amdgcn_readlane(cqk, 4 * g + 2) << 16) | (__builtin_amdgcn_readlane(cqk, 4 * g + 3) << 24);
        PEER_VACC(ra, 0); PEER_VACC(rb, 1);
#pragma unroll
        for (int j = 0; j < 2; ++j)
#pragma unroll
            for (int q = 0; q < 4; ++q) { const int xb = j * 16 + q * 4;
                *(LAS f32x4*)(red + hh * 2048 + j * 1024 + lane * 16 + q * 4) = (f32x4){(float)acc[xb] * sc, (float)acc[xb + 1] * sc, (float)acc[xb + 2] * sc, (float)acc[xb + 3] * sc}; }
        __syncthreads();
        f32x4 xs = *(const GAS f32x4*)(A.out + (size_t)n * DM + 4 * tid);
#pragma unroll
        for (int w8 = 0; w8 < 8; ++w8) xs = xs + *(const LAS f32x4*)(red + w8 * 2048 + 4 * tid);
        float ss = wave_sum((xs.x * xs.x + xs.y * xs.y) + (xs.z * xs.z + xs.w * xs.w));
        if (lane == 0) bred[hh] = ss;
        __syncthreads();
        float tot = 0.f;
#pragma unroll
        for (int w8 = 0; w8 < 8; ++w8) tot += bred[w8];
        const float r = 1.0f / sqrtf(tot * (1.f / 2048.f) + 1e-6f);
        const f32x4 fw = *(const GAS f32x4*)(A.in[25] + 4 * tid);
        *(GAS f32x4*)(A.out + (size_t)n * DM + 4 * tid) = xs * r * fw;
        __syncthreads();
        expert = nexpert; gate = ngate; su = nsu; sv = nsv;
    }
#undef PEER_TOPK
#undef PEER_LOADB
#undef PEER_UDOT
#undef PEER_VACC
}

template <int CTRL> __device__ __forceinline__ unsigned dppu(unsigned x) { return (unsigned)__builtin_amdgcn_update_dpp(0, (int)x, CTRL, 0xf, 0xf, false); }
__device__ __forceinline__ unsigned cexd(unsigned x, unsigned p, bool lower) { const unsigned mx = x > p ? x : p, mn = x > p ? p : x; return lower ? mx : mn; }
struct LaneBits { bool L1, L2, L4, L8; };
__device__ __forceinline__ unsigned dpp_xor4(unsigned x) { return dppu<0x1B>(dppu<0x141>(x)); }
__device__ __forceinline__ unsigned merge16(unsigned x, const LaneBits& B) { x = cexd(x, dppu<0x128>(x), B.L8); x = cexd(x, dpp_xor4(x), B.L4); x = cexd(x, dppu<0x4E>(x), B.L2); x = cexd(x, dppu<0xB1>(x), B.L1); return x; }
__device__ __forceinline__ unsigned sort16(unsigned x, const LaneBits& B) {
    x = cexd(x, dppu<0xB1>(x), B.L1);
    x = cexd(x, dppu<0x1B>(x), B.L2); x = cexd(x, dppu<0xB1>(x), B.L1);
    x = cexd(x, dppu<0x141>(x), B.L4); x = cexd(x, dppu<0x4E>(x), B.L2); x = cexd(x, dppu<0xB1>(x), B.L1);
    x = cexd(x, dppu<0x140>(x), B.L8); x = cexd(x, dpp_xor4(x), B.L4); x = cexd(x, dppu<0x4E>(x), B.L2); x = cexd(x, dppu<0xB1>(x), B.L1); return x; }
__device__ __forceinline__ unsigned top16_of_rows(unsigned x, int lane, const LaneBits& B) {
    unsigned p = (unsigned)__builtin_amdgcn_ds_bpermute((lane ^ 31) << 2, (int)x); x = x > p ? x : p; x = merge16(x, B);
    p = (unsigned)__builtin_amdgcn_ds_bpermute((lane ^ 47) << 2, (int)x); x = x > p ? x : p; x = merge16(x, B); return x; }
#define CEXV(ctrl_, L_) _Pragma("unroll") for (int i_ = 0; i_ < N; ++i_) x[i_] = cexd(x[i_], dppu<ctrl_>(x[i_]), L_)
#define CEXV4(L_) _Pragma("unroll") for (int i_ = 0; i_ < N; ++i_) x[i_] = cexd(x[i_], dpp_xor4(x[i_]), L_)
template <int N> __device__ __forceinline__ void merge16v(unsigned (&x)[N], const LaneBits& B) { CEXV(0x128, B.L8); CEXV4(B.L4); CEXV(0x4E, B.L2); CEXV(0xB1, B.L1); }
template <int N> __device__ __forceinline__ void sort16v(unsigned (&x)[N], const LaneBits& B) {
    CEXV(0xB1, B.L1);
    CEXV(0x1B, B.L2); CEXV(0xB1, B.L1);
    CEXV(0x141, B.L4); CEXV(0x4E, B.L2); CEXV(0xB1, B.L1);
    CEXV(0x140, B.L8); CEXV4(B.L4); CEXV(0x4E, B.L2); CEXV(0xB1, B.L1); }
template <int N> __device__ __forceinline__ void top16_of_rows_v(unsigned (&x)[N], int lane, const LaneBits& B) {
#pragma unroll
    for (int i = 0; i < N; ++i) { const unsigned p = (unsigned)__builtin_amdgcn_ds_bpermute((lane ^ 31) << 2, (int)x[i]); x[i] = x[i] > p ? x[i] : p; }
    merge16v<N>(x, B);
#pragma unroll
    for (int i = 0; i < N; ++i) { const unsigned p = (unsigned)__builtin_amdgcn_ds_bpermute((lane ^ 47) << 2, (int)x[i]); x[i] = x[i] > p ? x[i] : p; }
    merge16v<N>(x, B); }
#undef CEXV
#undef CEXV4
template <int NT> __device__ __forceinline__ void peer_topk_sort_w(const float (&s1)[NT][2], const float (&s2)[NT][2], LAS float* wsc, int lane, int ca, int cb, bool cvalid, const LaneBits& B, int (&expert)[NT], float (&gate)[NT]) {
    unsigned k[4 * NT], c[NT];
#pragma unroll
    for (int t = 0; t < NT; ++t) { k[4 * t] = (ord_key(s1[t][0]) & ~0x7fu) | (unsigned)lane; k[4 * t + 1] = (ord_key(s1[t][1]) & ~0x7fu) | (unsigned)(lane + 64);
        k[4 * t + 2] = (ord_key(s2[t][0]) & ~0x7fu) | (unsigned)lane; k[4 * t + 3] = (ord_key(s2[t][1]) & ~0x7fu) | (unsigned)(lane + 64); }
    sort16v<4 * NT>(k, B);
    unsigned h[2 * NT];
#pragma unroll
    for (int i = 0; i < 2 * NT; ++i) { const unsigned m = dppu<0x140>(k[2 * i + 1]); h[i] = k[2 * i] > m ? k[2 * i] : m; }
    merge16v<2 * NT>(h, B);
    top16_of_rows_v<2 * NT>(h, lane, B);
    unsigned a0[NT], b0[NT];
#pragma unroll
    for (int t = 0; t < NT; ++t) { a0[t] = h[2 * t]; b0[t] = h[2 * t + 1]; }
#pragma unroll
    for (int t = 0; t < NT; ++t) if (lane < 16) { LAS float* w = wsc + 64 * t; w[lane] = ord_val(a0[t] & ~0x7fu); w[16 + lane] = __int_as_float((int)(a0[t] & 0x7fu)); w[32 + lane] = ord_val(b0[t] & ~0x7fu); w[48 + lane] = __int_as_float((int)(b0[t] & 0x7fu)); }
    LDS_WAIT(); asm volatile("" ::: "memory");
#pragma unroll
    for (int t = 0; t < NT; ++t) { const LAS float* w = wsc + 64 * t; c[t] = cvalid ? ((ord_key(w[ca] + w[32 + cb]) & ~0xffu) | (unsigned)(ca * 16 + cb)) : 0u; }
    sort16v<NT>(c, B);
    top16_of_rows_v<NT>(c, lane, B);
#pragma unroll
    for (int t = 0; t < NT; ++t) { const LAS float* w = wsc + 64 * t; const int ia = (int)((c[t] >> 4) & 15u), ib = (int)(c[t] & 15u);
        const float gv = lane < 16 ? ord_val(c[t] & ~0xffu) : -3.0e38f; expert[t] = lane < 16 ? ((__float_as_int(w[16 + ia]) * 128 + __float_as_int(w[48 + ib])) & 16383) : 0;
        const float top = rowmax16(gv); const float e = lane < 16 ? __expf(gv - top) : 0.f; const float se = fmaxf(rowsum16(e), 1e-30f); gate[t] = e / se; }
    LDS_WAIT(); asm volatile("" ::: "memory");
}
__device__ __forceinline__ v4u ldrow(__amdgpu_buffer_rsrc_t tab, unsigned row, unsigned lane16) {
    return __builtin_amdgcn_raw_buffer_load_b128(tab, (int)lane16, __builtin_amdgcn_readfirstlane((int)(row << 10)), 0); }
#ifndef P3_LOG
#define P3_LOG 1
#endif
#ifndef P3_LOGU
#define P3_LOGU 2
#endif
__device__ __forceinline__ void peer_phase3(const Args& A, LAS unsigned char* lds, int vcu, int G, int bx, int tid) {
    unsigned char* ws = A.ws;
    const int lane = tid & 63, w = tid >> 6;
    const float* SC = (const float*)(ws + WS_SC); const unsigned char* U8 = ws + WS_U8; const unsigned char* V8 = ws + WS_V8;
    const float* SCU = (const float*)(ws + WS_SCU); const float* SCV = (const float*)(ws + WS_SCV);
    LAS unsigned short* EID = (LAS unsigned short*)(lds + w * 8192);
    LAS float* GATE = (LAS float*)(lds + w * 8192 + 1024);
    LAS float* ZL = (LAS float*)(lds + w * 8192 + 3072);
    LAS float* wsc = (LAS float*)(lds + w * 8192 + 5120);
    LAS unsigned* LIST = (LAS unsigned*)(lds + w * 8192 + 5632);
    LAS unsigned char* CQB = lds + w * 8192 + 6208;
    int ca = 0, cb = 0; bool cvalid = false;
    { int base = 0;
#pragma unroll
      for (int a = 0; a < 16; ++a) { const int cnt = 16 / (a + 1); if (lane >= base && lane < base + cnt) { ca = a; cb = lane - base; cvalid = true; } base += cnt; } }
    const int half = lane >> 5, l32 = lane & 31;
    const unsigned lane16 = (unsigned)lane * 16u;
    const __amdgpu_buffer_rsrc_t rsU = __builtin_amdgcn_make_buffer_rsrc((void*)U8, 0, 16384 * 1024, 0x00020000), rsV = __builtin_amdgcn_make_buffer_rsrc((void*)V8, 0, 16384 * 1024, 0x00020000);
    const bool lb3 = (lane & 8) != 0, lb2 = (lane & 4) != 0, lb1 = (lane & 2) != 0;
    const LaneBits LB{(lane & 1) == 0, (lane & 2) == 0, (lane & 4) == 0, (lane & 8) == 0};
    const int rot = (P3_LOG >= 3) ? ((1 << P3_LOG) / 8) * (bx & 7) : ((bx & 7) >> (3 - P3_LOG));
    const int rotu = (P3_LOGU >= 3) ? ((1 << P3_LOGU) / 8) * (bx & 7) : ((bx & 7) >> (3 - P3_LOGU));
    float nsc[2][4];
#pragma unroll
    for (int t = 0; t < 2; ++t) { const float* sc = SC + (size_t)((vcu + G * w) * 8 + t) * 256 + lane; nsc[t][0] = sc[0]; nsc[t][1] = sc[64]; nsc[t][2] = sc[128]; nsc[t][3] = sc[192]; }
#pragma unroll 1
    for (int task = 0; task < 32; task += 2) { const int tq = task >> 3, hd = task & 7;
        const float c1[2][2] = {{nsc[0][0], nsc[0][1]}, {nsc[1][0], nsc[1][1]}}, c2[2][2] = {{nsc[0][2], nsc[0][3]}, {nsc[1][2], nsc[1][3]}};
        if (task + 2 < 32) {
#pragma unroll
            for (int t = 0; t < 2; ++t) { const int t1 = task + 2 + t; const float* sc = SC + (size_t)((vcu + G * (w + 8 * (t1 >> 3))) * 8 + (t1 & 7)) * 256 + lane; nsc[t][0] = sc[0]; nsc[t][1] = sc[64]; nsc[t][2] = sc[128]; nsc[t][3] = sc[192]; } }
        int expert[2]; float gate[2]; peer_topk_sort_w<2>(c1, c2, wsc, lane, ca, cb, cvalid, LB, expert, gate);
        if (lane < 16) { EID[tq * 128 + hd * 16 + lane] = (unsigned short)expert[0]; GATE[tq * 128 + hd * 16 + lane] = gate[0]; EID[tq * 128 + (hd + 1) * 16 + lane] = (unsigned short)expert[1]; GATE[tq * 128 + (hd + 1) * 16 + lane] = gate[1]; }
        LDS_WAIT(); asm volatile("" ::: "memory");
    }
    unsigned idp[4]; int xh[4][4], xl[4][4]; float sx[4], sxh[4];
#pragma unroll
    for (int tq = 0; tq < 4; ++tq) { const int n = vcu + G * (w + 8 * tq); idp[tq] = (unsigned)EID[tq * 128 + lane] | ((unsigned)EID[tq * 128 + 64 + lane] << 16);
        const float pq = lane < 32 ? ((const float*)(ws + WS_PART))[(size_t)n * 32 + lane] : 0.f; const float rstd = 1.0f / sqrtf(wave_sum(pq) * (1.f / 2048.f) + 1e-6f);
        float xf[32]; float am = 0.f;
#pragma unroll
        for (int j = 0; j < 2; ++j)
#pragma unroll
            for (int q = 0; q < 2; ++q) { const v4u t = *(const GAS v4u*)((const bf16*)(ws + WS_H2) + (size_t)n * DM + j * 1024 + lane * 16 + q * 8); const int xb = j * 16 + q * 8;
                xf[xb] = bflo(t.x); xf[xb + 1] = bfhi(t.x); xf[xb + 2] = bflo(t.y); xf[xb + 3] = bfhi(t.y); xf[xb + 4] = bflo(t.z); xf[xb + 5] = bfhi(t.z); xf[xb + 6] = bflo(t.w); xf[xb + 7] = bfhi(t.w); }
#pragma unroll
        for (int i = 0; i < 32; ++i) am = fmaxf(am, fabsf(xf[i]));
        am = fmaxf(wave_max(am), 1e-30f); const float inv = 119.0f / am; sx[tq] = am * rstd * (1.0f / 119.0f); int xsum = 0;
#pragma unroll
        for (int k = 0; k < 4; ++k) { unsigned ph = 0, pl = 0;
#pragma unroll
            for (int nn = 0; nn < 8; ++nn) { const int v = (int)rintf(xf[8 * k + nn] * inv); xsum += v; const int lo = ((v + 8) & 15) - 8, hi = (v - lo) >> 4; pl |= ((unsigned)lo & 0xfu) << (4 * nn); ph |= ((unsigned)hi & 0xfu) << (4 * nn); }
            xh[tq][k] = (int)ph; xl[tq][k] = (int)pl; }
        sxh[tq] = 0.5f * wave_sum((float)xsum); }
#define P3_ULOAD(buf_, b_) do { const v4u e0_ = *(const LAS v4u*)(LIST + 8 * (b_)), e1_ = *(const LAS v4u*)(LIST + 8 * (b_) + 4); const unsigned ee_[8] = {e0_.x, e0_.y, e0_.z, e0_.w, e1_.x, e1_.y, e1_.z, e1_.w}; \
        _Pragma("unroll") for (int i = 0; i < 8; ++i) buf_[i] = ldrow(rsU, ee_[i] & 0xffffu, lane16); } while (0)
#define P3_UCOMP(buf_, b_, tq_) do { int zi[8]; \
        _Pragma("unroll") for (int i = 0; i < 8; ++i) { int a0 = 0; \
            _Pragma("unroll") for (int k = 0; k < 4; ++k) a0 = __builtin_amdgcn_sdot8((int)buf_[i][k], xh[tq_][k], a0, false); \
            a0 <<= 4; \
            _Pragma("unroll") for (int k = 0; k < 4; ++k) a0 = __builtin_amdgcn_sdot8((int)buf_[i][k], xl[tq_][k], a0, false); \
            zi[i] = a0; } \
          \
        int t4[4], t2[2]; \
        _Pragma("unroll") for (int i = 0; i < 4; ++i) { const int keep = lb3 ? zi[i + 4] : zi[i], send = lb3 ? zi[i] : zi[i + 4]; t4[i] = keep + dppi<0x128>(send); } \
        _Pragma("unroll") for (int i = 0; i < 2; ++i) { const int keep = lb2 ? t4[i + 2] : t4[i], send = lb2 ? t4[i] : t4[i + 2]; t2[i] = keep + dppi<0x141>(send); } \
        int zs; { const int keep = lb1 ? t2[1] : t2[0], send = lb1 ? t2[0] : t2[1]; zs = keep + dppi<0x4E>(send); } \
        zs += dppi<0xB1>(zs); \
        zs += __shfl_xor(zs, 16); zs += __shfl_xor(zs, 32); \
        const unsigned mye_ = LIST[8 * (b_) + ((lane >> 1) & 7)]; if (lane < 16 && !(lane & 1) && (mye_ >> 16) < 128u) ZL[(tq_) * 128 + (int)(mye_ >> 16)] = (float)zs; } while (0)
#pragma unroll 1
    for (int r = 0; r < (1 << P3_LOGU); ++r) { const int s = (r + rotu) & ((1 << P3_LOGU) - 1);
        __syncthreads();
#pragma unroll
        for (int tq = 0; tq < 4; ++tq) { const int id0 = (int)(idp[tq] & 0xffffu), id1 = (int)(idp[tq] >> 16);
            const bool s0 = (id0 >> (14 - P3_LOGU)) == s, s1 = (id1 >> (14 - P3_LOGU)) == s;
            const unsigned long long m0 = __ballot(s0), m1 = __ballot(s1); const int c0 = (int)__builtin_popcountll(m0), cnt = c0 + (int)__builtin_popcountll(m1), nb = ((cnt + 3) >> 2) >> 1, tail = ((cnt + 3) >> 2) & 1;
            if (s0) LIST[__builtin_amdgcn_mbcnt_hi((unsigned)(m0 >> 32), __builtin_amdgcn_mbcnt_lo((unsigned)m0, 0u))] = (unsigned)id0 | ((unsigned)lane << 16);
            if (s1) LIST[c0 + __builtin_amdgcn_mbcnt_hi((unsigned)(m1 >> 32), __builtin_amdgcn_mbcnt_lo((unsigned)m1, 0u))] = (unsigned)id1 | ((unsigned)(64 + lane) << 16);
            if (lane < 4 && cnt + lane < 4 * ((cnt + 3) >> 2)) LIST[cnt + lane] = (unsigned)(s << (14 - P3_LOGU)) | (0xffu << 16);
            LDS_WAIT(); asm volatile("" ::: "memory");
            v4u ua[8], ub[8];
            if (nb > 0) P3_ULOAD(ua, 0);
#pragma unroll 1
            for (int b = 0; b < nb; b += 2) {
                if (b + 1 < nb) P3_ULOAD(ub, b + 1);
                P3_UCOMP(ua, b, tq);
                if (b + 1 < nb) { if (b + 2 < nb) P3_ULOAD(ua, b + 2); P3_UCOMP(ub, b + 1, tq); } }
            if (tail) {
                const v4u e_ = *(const LAS v4u*)(LIST + 8 * nb); const unsigned ee_[4] = {e_.x, e_.y, e_.z, e_.w}; v4u ut[4];
#pragma unroll
                for (int i = 0; i < 4; ++i) ut[i] = ldrow(rsU, ee_[i] & 0xffffu, lane16);
                int t4[4];
#pragma unroll
                for (int i = 0; i < 4; ++i) { int a0 = 0;
#pragma unroll
                    for (int k = 0; k < 4; ++k) a0 = __builtin_amdgcn_sdot8((int)ut[i][k], xh[tq][k], a0, false);
                    a0 <<= 4;
#pragma unroll
                    for (int k = 0; k < 4; ++k) a0 = __builtin_amdgcn_sdot8((int)ut[i][k], xl[tq][k], a0, false);
                    t4[i] = a0 + dppi<0x128>(a0); }
                int t2[2];
#pragma unroll
                for (int i = 0; i < 2; ++i) { const int keep = lb2 ? t4[i + 2] : t4[i], send = lb2 ? t4[i] : t4[i + 2]; t2[i] = keep + dppi<0x141>(send); }
                int zs; { const int keep = lb1 ? t2[1] : t2[0], send = lb1 ? t2[0] : t2[1]; zs = keep + dppi<0x4E>(send); }
                zs += dppi<0xB1>(zs);
                zs += __shfl_xor(zs, 16); zs += __shfl_xor(zs, 32);
                const unsigned mye_ = LIST[8 * nb + ((lane >> 1) & 3)]; if (lane < 8 && !(lane & 1) && (mye_ >> 16) < 128u) ZL[tq * 128 + (int)(mye_ >> 16)] = (float)zs; }
            LDS_WAIT(); asm volatile("" ::: "memory"); } }
#undef P3_ULOAD
#undef P3_UCOMP
    LDS_WAIT(); asm volatile("" ::: "memory");
    unsigned cqp[4]; float scv[4], k1f[4];
#pragma unroll
    for (int tq = 0; tq < 4; ++tq) { const int id0 = (int)(idp[tq] & 0xffffu), id1 = (int)(idp[tq] >> 16);
        const float z0 = ZL[tq * 128 + lane], z1 = ZL[tq * 128 + 64 + lane], g0 = GATE[tq * 128 + lane], g1 = GATE[tq * 128 + 64 + lane];
        const float c0 = gelu_erf((z0 + sxh[tq]) * SCU[id0] * sx[tq]) * g0 * SCV[id0], c1 = gelu_erf((z1 + sxh[tq]) * SCU[id1] * sx[tq]) * g1 * SCV[id1];
        const float cmax = fmaxf(wave_max(fmaxf(fabsf(c0), fabsf(c1))), 1e-30f), inv = 127.0f / cmax; const int q0 = (int)rintf(c0 * inv), q1 = (int)rintf(c1 * inv);
        cqp[tq] = ((unsigned)q0 & 0xffu) | (((unsigned)q1 & 0xffu) << 8); scv[tq] = cmax * (1.0f / 127.0f); k1f[tq] = wave_sum((float)(q0 + q1)); }
    int accA[4][16], accL[4][16];
#pragma unroll
    for (int tq = 0; tq < 4; ++tq)
#pragma unroll
        for (int i = 0; i < 16; ++i) { accA[tq][i] = 0; accL[tq][i] = 0; }
#define P3_VLOAD(buf_, g_) do { const v4u e_ = *(const LAS v4u*)(LIST + 4 * (g_)); const unsigned ee_[4] = {e_.x, e_.y, e_.z, e_.w}; \
        _Pragma("unroll") for (int i = 0; i < 4; ++i) buf_[i] = ldrow(rsV, ee_[i], lane16); } while (0)
#define P3_VCOMP(buf_, g_, tq_) do { const int cqg_ = (int)*(const LAS unsigned*)(CQB + 4 * (g_)); \
        _Pragma("unroll") for (int k = 0; k < 4; ++k) { const unsigned w0 = buf_[0][k], w1 = buf_[1][k], w2 = buf_[2][k], w3 = buf_[3][k]; \
            const unsigned t01l = __builtin_amdgcn_perm(w1, w0, 0x05010400u), t01h = __builtin_amdgcn_perm(w1, w0, 0x07030602u), t23l = __builtin_amdgcn_perm(w3, w2, 0x05010400u), t23h = __builtin_amdgcn_perm(w3, w2, 0x07030602u); \
            const unsigned T0 = __builtin_amdgcn_perm(t23l, t01l, 0x05040100u), T1 = __builtin_amdgcn_perm(t23l, t01l, 0x07060302u), T2 = __builtin_amdgcn_perm(t23h, t01h, 0x05040100u), T3 = __builtin_amdgcn_perm(t23h, t01h, 0x07060302u); \
            const int xb = k * 4; \
            accA[tq_][xb]     = __builtin_amdgcn_sdot4((int)T0, cqg_, accA[tq_][xb], false);     accL[tq_][xb]     = __builtin_amdgcn_sdot4((int)(T0 & 0x0f0f0f0fu), cqg_, accL[tq_][xb], false); \
            accA[tq_][xb + 1] = __builtin_amdgcn_sdot4((int)T1, cqg_, accA[tq_][xb + 1], false); accL[tq_][xb + 1] = __builtin_amdgcn_sdot4((int)(T1 & 0x0f0f0f0fu), cqg_, accL[tq_][xb + 1], false); \
            accA[tq_][xb + 2] = __builtin_amdgcn_sdot4((int)T2, cqg_, accA[tq_][xb + 2], false); accL[tq_][xb + 2] = __builtin_amdgcn_sdot4((int)(T2 & 0x0f0f0f0fu), cqg_, accL[tq_][xb + 2], false); \
            accA[tq_][xb + 3] = __builtin_amdgcn_sdot4((int)T3, cqg_, accA[tq_][xb + 3], false); accL[tq_][xb + 3] = __builtin_amdgcn_sdot4((int)(T3 & 0x0f0f0f0fu), cqg_, accL[tq_][xb + 3], false); } } while (0)
#pragma unroll 1
    for (int r = 0; r < (1 << P3_LOG); ++r) { const int s = (r + rot) & ((1 << P3_LOG) - 1);
        __syncthreads();
#pragma unroll
        for (int tq = 0; tq < 4; ++tq) { const int id0 = (int)(idp[tq] & 0xffffu), id1 = (int)(idp[tq] >> 16); const int cq0 = (int)(cqp[tq] & 0xffu), cq1 = (int)((cqp[tq] >> 8) & 0xffu);
            const bool s0 = (id0 >> (14 - P3_LOG)) == s, s1 = (id1 >> (14 - P3_LOG)) == s;
            const unsigned long long m0 = __ballot(s0), m1 = __ballot(s1); const int c0 = (int)__builtin_popcountll(m0), cnt = c0 + (int)__builtin_popcountll(m1), ng = (cnt + 3) >> 2;
            { const int p0 = (int)__builtin_amdgcn_mbcnt_hi((unsigned)(m0 >> 32), __builtin_amdgcn_mbcnt_lo((unsigned)m0, 0u)), p1 = c0 + (int)__builtin_amdgcn_mbcnt_hi((unsigned)(m1 >> 32), __builtin_amdgcn_mbcnt_lo((unsigned)m1, 0u));
              if (s0) { LIST[p0] = (unsigned)id0; CQB[p0] = (unsigned char)cq0; }
              if (s1) { LIST[p1] = (unsigned)id1; CQB[p1] = (unsigned char)cq1; }
              if (lane < 4 && cnt + lane < 4 * ng) { LIST[cnt + lane] = (unsigned)(s << (14 - P3_LOG)); CQB[cnt + lane] = 0; } }
            LDS_WAIT(); asm volatile("" ::: "memory");
            v4u va[4], vb[4];
            if (ng > 0) P3_VLOAD(va, 0);
#pragma unroll 1
            for (int g = 0; g < ng; g += 2) {
                if (g + 1 < ng) P3_VLOAD(vb, g + 1);
                P3_VCOMP(va, g, tq);
                if (g + 1 < ng) { if (g + 2 < ng) P3_VLOAD(va, g + 2); P3_VCOMP(vb, g + 1, tq); } }
            LDS_WAIT(); asm volatile("" ::: "memory"); } }
#undef P3_VLOAD
#undef P3_VCOMP
#pragma unroll
    for (int tq = 0; tq < 4; ++tq) { const int n = vcu + G * (w + 8 * tq); float xs[32]; float ss = 0.f;
#pragma unroll
        for (int j = 0; j < 2; ++j)
#pragma unroll
            for (int q = 0; q < 4; ++q) { const f32x4 t = *(const GAS f32x4*)(A.out + (size_t)n * DM + j * 1024 + lane * 16 + q * 4); const int xb = j * 16 + q * 4;
                const int y0 = xb >> 1, y1 = y0 + 1; const float ke = -7.5f * k1f[tq], ko = 0.5f * k1f[tq];
                xs[xb] = t.x + ((float)accL[tq][y0] + ke) * scv[tq]; xs[xb + 1] = t.y + ((float)(accA[tq][y0] - accL[tq][y0]) * 0.0625f + ko) * scv[tq];
                xs[xb + 2] = t.z + ((float)accL[tq][y1] + ke) * scv[tq]; xs[xb + 3] = t.w + ((float)(accA[tq][y1] - accL[tq][y1]) * 0.0625f + ko) * scv[tq];
                ss += (xs[xb] * xs[xb] + xs[xb + 1] * xs[xb + 1]) + (xs[xb + 2] * xs[xb + 2] + xs[xb + 3] * xs[xb + 3]); }
        const float rr = 1.0f / sqrtf(wave_sum(ss) * (1.f / 2048.f) + 1e-6f);
#pragma unroll
        for (int j = 0; j < 2; ++j)
#pragma unroll
            for (int q = 0; q < 4; ++q) { const int xb = j * 16 + q * 4; const f32x4 fw = *(const GAS f32x4*)(A.in[25] + j * 1024 + lane * 16 + q * 4);
                *(GAS f32x4*)(A.out + (size_t)n * DM + j * 1024 + lane * 16 + q * 4) = (f32x4){xs[xb] * rr * fw.x, xs[xb + 1] * rr * fw.y, xs[xb + 2] * rr * fw.z, xs[xb + 3] * rr * fw.w}; } }
}

constexpr int NPHASE = 12;
#ifndef USE_CG
#define USE_CG 0
#endif
__global__ void __launch_bounds__(NTHR, 2) fwd_kernel(Args args) {
    extern __shared__ __attribute__((aligned(16))) unsigned char lds_raw[];
    LAS unsigned char* lds = (LAS unsigned char*)lds_raw;
    const int tid = threadIdx.x, G = gridDim.x, bx = blockIdx.x;
    const int vcu = (G % 8 == 0) ? (bx % 8) * (G / 8) + bx / 8 : bx;
    unsigned char* ws = args.ws;
    for (int u = tid; u < (LDS_BYTES - LDSCTL_OFF) / 4; u += NTHR) ((LAS unsigned*)(lds + LDSCTL_OFF))[u] = 0u;
    __syncthreads();
    const int lo = args.ph_lo, hi = args.ph_hi;
    const bool use_bar = (hi - lo) > 1;
    XcdBarrier bar; bar.bar = (unsigned*)(ws + WS_CTL) + CW_BAR; bar.x = 0; bar.st = nullptr;
    if (use_bar && !USE_CG) bar = xcd_barrier_post((unsigned*)(ws + WS_CTL) + CW_BAR, (volatile LAS unsigned*)(lds + MISC_OFF) + 8);
#ifndef PHMASK
#define PHMASK 0xfff
#endif
#define IN(k) (((PHMASK >> (k)) & 1) && lo <= (k) && (k) < hi)
#if USE_CG
#define SEAM(k) do { if (IN(k) && IN((k) + 1)) { __syncthreads(); cooperative_groups::this_grid().sync(); } } while (0)
#else
#define SEAM(k) do { if (IN(k) && IN((k) + 1)) xcd_barrier(bar); } while (0)
#endif
    typedef pg8::bf16_t pb;
    if (IN(0)) { for (int st = bx; st < IN_COLS / 32; st += G) p0_win_strip(args, lds, st, tid);
        p0_prologue(args, lds, vcu, G, tid); VM_WAIT(); __syncthreads(); } SEAM(0);
    constexpr int P1_TILES = 32;
    if (IN(1)) { pg8::Gemm g{(const pb*)(ws + WS_H), (const pb*)(ws + WS_WIN), NTOK, P1_TILES * 256, DM / 2}; pg8::StaticOrder S; S.init(NTOK, P1_TILES * 256, G, bx);
        pg8::EpiZ E{(pb*)(ws + WS_QB), (pb*)(ws + WS_KB), (pb*)(ws + WS_VR), (pb*)(ws + WS_GB), (pb*)(ws + WS_ZR), (pb*)(ws + WS_SG), (const float*)(ws + WS_ROT), (const float*)(ws + WS_ROT) + 4096 * 128, (const float*)(ws + WS_SA), (const unsigned*)(ws + WS_CTL + WS_SBM)};
        pg8::gemm_phase<pg8::EpiZ, pg8::StaticOrder, true, true, true>(lds, g, S, E); } SEAM(1);
    constexpr int P4_TILES = 12;
    if (IN(2)) {
        if (bx < 32) { pg8::Gemm g{(const pb*)(ws + WS_H), (const pb*)(ws + WS_WIN), NTOK, IN_COLS, DM / 2}; pg8::SubOrder S{NTOK / 256, 1, P1_TILES + P4_TILES, 32, bx};
            pg8::EpiZ E{(pb*)(ws + WS_QB), (pb*)(ws + WS_KB), (pb*)(ws + WS_VR), (pb*)(ws + WS_GB), (pb*)(ws + WS_ZR), (pb*)(ws + WS_SG), (const float*)(ws + WS_ROT), (const float*)(ws + WS_ROT) + 4096 * 128, (const float*)(ws + WS_SA), (const unsigned*)(ws + WS_CTL + WS_SBM)};
            pg8::gemm_phase<pg8::EpiZ, pg8::SubOrder, true, true, true>(lds, g, S, E); }
        else { const int bi = bx - 32, v2 = (bi & 7) * 28 + (bi >> 3); p2a_lerp(args, v2, 224, tid); p2a_ret_transpose(args, lds, v2, 224, tid); }
        VM_WAIT(); __syncthreads(); } SEAM(2);
    if (IN(3)) { int k256 = 256; asm volatile("" : "+s"(k256)); pg8::Gemm g{(const pb*)(ws + WS_L), (const pb*)(ws + WS_WLORA), NTOK, 3072, k256}; pg8::StaticOrder S; S.init(NTOK, 3072, G, bx);
        pg8::EpiLora E{(float*)(ws + WS_DEC), (pb*)(ws + WS_AB), (pb*)(ws + WS_GG), args.in[6], args.in[8]};
        pg8::gemm_phase<pg8::EpiLora, pg8::StaticOrder, true, true>(lds, g, S, E);
        if (bx >= 128) p4_w_absmax(args, bx - 128, 128, tid);
} SEAM(3);
    if (IN(4)) { const int grp = bx >> 3, xi = bx & 7;
        if (grp >= 8 && grp < 24) { const int g = grp - 8; rwkv_scan_unit(args, lds, (g >> 2) * 8 + xi, g & 3, g * 8 + xi, 128, tid); }
        else { const int gi = grp < 8 ? bx : bx - 128; constexpr int NG = 128; unsigned* gcnt = (unsigned*)(ws + WS_CTL) + CW_GBAR;
            { pg8::Gemm g{(const pb*)(ws + WS_H), (const pb*)(ws + WS_WIN), NTOK, IN_COLS, DM / 2}; pg8::SubOrder S{NTOK / 256, P4_TILES, P1_TILES, NG, gi};
              pg8::EpiZ E{(pb*)(ws + WS_QB), (pb*)(ws + WS_KB), (pb*)(ws + WS_VR), (pb*)(ws + WS_GB), (pb*)(ws + WS_ZR), (pb*)(ws + WS_SG), (const float*)(ws + WS_ROT), (const float*)(ws + WS_ROT) + 4096 * 128, (const float*)(ws + WS_SA), (const unsigned*)(ws + WS_CTL + WS_SBM)};
              pg8::gemm_phase<pg8::EpiZ, pg8::SubOrder, true, true, true>(lds, g, S, E); }
            const int nslow = P4_TILES * 32 - 3 * NG;
            const int u0 = gi < nslow ? gi : nslow + (gi - nslow) * ((512 - nslow) / (NG - nslow)), un = gi < nslow ? 1 : (512 - nslow) / (NG - nslow);
            p4_wq_copy(args, gi, NG, tid);
            for (int u = u0; u < u0 + un; u += 2) ret_unit_a2(args, lds, u >> 6, u & 63, tid);
            group_barrier(gcnt, NG, tid);
            ret_scan_b(args, gi, NG, tid);
            group_barrier(gcnt, 2 * NG, tid);
            for (int u = u0; u < u0 + un; ++u) ret_unit_c(args, u >> 6, u & 63, tid);
            __syncthreads();
            { int k256b = 256; asm volatile("" : "+s"(k256b)); pg8::Gemm g2{(const pb*)(ws + WS_KEYS), (const pb*)(ws + WS_WQ), 256, 8 * 2048, k256b}; pg8::StaticOrder S2; S2.init(256, 8 * 2048, NG, gi);
              pg8::EpiGen<5> E2{nullptr, 0, nullptr, (pb*)(ws + WS_WQK), nullptr, 0};
              pg8::gemm_phase<pg8::EpiGen<5>, pg8::StaticOrder, true, true>(lds, g2, S2, E2); }
            VM_WAIT(); __syncthreads(); p4_weight_transposes(args, lds, gi, NG, tid); }
        VM_WAIT(); __syncthreads(); } SEAM(4);
    if (IN(5)) { p4_post(args, vcu, G, tid); VM_WAIT(); __syncthreads(); } SEAM(5);
    if (IN(6)) { pg8::StaticOrder S; S.init(NTOK, DM, G, bx);
        { pg8::Gemm g{(const pb*)(ws + WS_ORN), (const pb*)(ws + WS_WR), NTOK, DM, RW / 2}; pg8::EpiGen<0> E{(const pb*)(ws + WS_SG), 0, (float*)(ws + WS_M1), nullptr, nullptr, 0, (const float*)(ws + WS_SAR), (const unsigned*)(ws + WS_CTL + WS_SBRW)};
          pg8::gemm_phase<pg8::EpiGen<0>, pg8::StaticOrder, true, true, true>(lds, g, S, E); }
        VM_WAIT(); __syncthreads();
        { pg8::Gemm g{(const pb*)(ws + WS_OWN), (const pb*)(ws + WS_WW), NTOK, DM, RW / 2}; pg8::EpiGen<1> E{(const pb*)(ws + WS_SG), 2048, (float*)(ws + WS_M1), (pb*)(ws + WS_MG), nullptr, 0, (const float*)(ws + WS_SAW), (const unsigned*)(ws + WS_CTL + WS_SBRW) + 2048};
          pg8::gemm_phase<pg8::EpiGen<1>, pg8::StaticOrder, true, true, true>(lds, g, S, E); } } SEAM(6);
    if (IN(7)) { pg8::Gemm g{(const pb*)(ws + WS_MG), (const pb*)(ws + WS_WO), NTOK, DM, DM}; pg8::StaticOrder S; S.init(NTOK, DM, G, bx);
        pg8::EpiX1 E{args.in[0], args.out, (pb*)(ws + WS_H2), args.in[19], (float*)(ws + WS_PART)};
        pg8::gemm_phase<pg8::EpiX1, pg8::StaticOrder, true, true>(lds, g, S, E); } SEAM(7);
    if (IN(9)) { pg8::Gemm g{(const pb*)(ws + WS_H2), (const pb*)(ws + WS_WQK), NTOK, DM, DM}; pg8::StaticOrder S; S.init(NTOK, DM, G, bx);
        LAS float* rtab = (LAS float*)(lds + LDSCTL_OFF + 1024);
        { pg8::Unit u0; if (S.next(0, u0)) { const int row = tid >> 1, hq = tid & 1; const float* pp = (const float*)(ws + WS_PART) + (size_t)(u0.pm * 256 + row) * 32 + 16 * hq; float sq = 0.f;
#pragma unroll
              for (int q = 0; q < 4; ++q) { const f32x4 t = *(const GAS f32x4*)(pp + 4 * q); sq += (t.x + t.y) + (t.z + t.w); }
              sq += __shfl_xor(sq, 1); if (hq == 0) rtab[row] = 1.0f / sqrtf(sq * (1.f / 2048.f) + 1e-6f); } }
        __syncthreads();
        pg8::EpiScore E{(float*)(ws + WS_SC), (const LAS float*)rtab};
        pg8::gemm_phase<pg8::EpiScore, pg8::StaticOrder, true, true>(lds, g, S, E); }
    SEAM(10);
#ifndef PEER_V3
#define PEER_V3 1
#endif
    if (IN(11)) { if (PEER_V3) peer_phase3(args, lds, vcu, G, use_bar ? (int)bar.x : bx, tid); else peer_phase(args, lds, vcu, G, tid); }
#undef IN
#undef SEAM
}

#ifndef MK_PER_PHASE
#define MK_PER_PHASE 0
#endif
extern "C" void kernel_launch(void* const* d_in, const int* in_sizes, int n_in, void* d_out, int out_size, void* d_ws, size_t ws_size, hipStream_t stream) {
    static int grid = 0;
    if (grid == 0) {
        if (n_in != 26 || in_sizes[0] != NTOK * DM || out_size != NTOK * DM || ws_size < WS_END) {
            fprintf(stderr, "kernel_launch: unexpected problem: n_in %d in0 %d out %d ws %zu (need %zu); nothing launched\n", n_in, n_in > 0 ? in_sizes[0] : -1, out_size, ws_size, (size_t)WS_END); grid = -1; return; }
        int dev = 0, cus = 0, per_cu = 0;
        if (hipGetDevice(&dev) != hipSuccess || hipDeviceGetAttribute(&cus, hipDeviceAttributeMultiprocessorCount, dev) != hipSuccess) { fprintf(stderr, "kernel_launch: device query failed\n"); grid = -1; return; }
        if (hipFuncSetAttribute((const void*)fwd_kernel, hipFuncAttributeMaxDynamicSharedMemorySize, LDS_BYTES) != hipSuccess) { fprintf(stderr, "kernel_launch: hipFuncSetAttribute failed\n"); grid = -1; return; }
        if (hipOccupancyMaxActiveBlocksPerMultiprocessor(&per_cu, (const void*)fwd_kernel, NTHR, LDS_BYTES) != hipSuccess || per_cu < 1) { fprintf(stderr, "kernel_launch: occupancy query says %d blocks/CU; nothing launched\n", per_cu); (void)hipGetLastError(); grid = -1; return; }
        grid = cus;
        if (grid != 256) { fprintf(stderr, "kernel_launch: built for a 256-CU device, found %d CUs; nothing launched\n", cus); grid = -1; return; }
    }
    if (grid < 0) return;
    if (hipMemsetAsync((char*)d_ws + WS_CTL, 0, CTL_ZERO_BYTES, stream) != hipSuccess) { fprintf(stderr, "kernel_launch: memset failed\n"); return; }
    Args a{};
    for (int i = 0; i < 26; ++i) a.in[i] = (const float*)d_in[i];
    a.out = (float*)d_out; a.ws = (unsigned char*)d_ws;
#if MK_PER_PHASE
    for (int p = 0; p < NPHASE; ++p) { a.ph_lo = p; a.ph_hi = p + 1; hipLaunchKernelGGL(fwd_kernel, dim3(grid), dim3(NTHR), LDS_BYTES, stream, a); }
#else
    a.ph_lo = 0; a.ph_hi = NPHASE;
    void* kargs[] = {&a};
    hipError_t e = hipLaunchCooperativeKernel((const void*)fwd_kernel, dim3(grid), dim3(NTHR), kargs, LDS_BYTES, stream);
    if (e != hipSuccess) fprintf(stderr, "kernel_launch: cooperative launch failed: %s\n", hipGetErrorString(e));
#endif
}
```

```cpp
#include <hip/hip_runtime.h>
#include <hip/hip_cooperative_groups.h>
#include <cstdio>
#include <cstdint>
namespace pg8 {
#define PG8_LAS __attribute__((address_space(3)))
typedef unsigned short bf16_t;
typedef short bf16x8 __attribute__((ext_vector_type(8)));
typedef float f32x4 __attribute__((ext_vector_type(4)));
typedef unsigned u32x4 __attribute__((ext_vector_type(4)));
typedef int i32x4 __attribute__((ext_vector_type(4)));
constexpr int BM = 256, BK = 64, HALF = 128, HTB = HALF * BK * 2  , STAGE_BYTES = 8 * HTB, NXCD = 8, WGM = 8;

__host__ __device__ __forceinline__ int lds_byte(int r, int c) { const int st = (r >> 4) * 2 + (c >> 5), rr = r & 15, cc = c & 31, ob = rr * 64 + cc * 2; return st * 1024 + (ob ^ (((ob >> 9) & 1) << 5)); }
__host__ __device__ __forceinline__ void stage_rc(int b, int& R, int& C) { const int st = b / 1024, sb = b % 1024, swz = sb ^ (((sb >> 9) & 1) << 5); R = (st >> 1) * 16 + swz / 64; C = (st & 1) * 32 + (swz % 64) / 2; }
__host__ __device__ __forceinline__ int perm32(int rho) { const int n = rho >> 4, i = rho & 15; return 8 * (i >> 2) + 4 * n + (i & 3); }

struct Unit { int pm, pn; };
struct Gemm { const bf16_t* A; const bf16_t* Bt; int M, N, K; };

struct StaticOrder {
    int nM, nN, nwg, G, c;
    __host__ __device__ __forceinline__ void init(int M, int N, int G_, int c_) { nM = M / BM; nN = N / BM; nwg = nM * nN; G = G_; c = c_; }
    __host__ __device__ __forceinline__ bool next(int i, Unit& u) const {
        const long L = (long)i * G + c; if (L >= nwg) return false;
        int wgid = (int)L; { const int q = nwg / NXCD, r = nwg % NXCD, xcd = wgid % NXCD, off = wgid / NXCD; wgid = (xcd < r ? xcd * (q + 1) : r * (q + 1) + (xcd - r) * q) + off; }
        const int nig = WGM * nN, gid = wgid / nig, fm = gid * WGM, gsz = (nM - fm) < WGM ? (nM - fm) : WGM;
        u.pm = fm + ((wgid % nig) % gsz); u.pn = (wgid % nig) / gsz; return true;
    }
    __device__ __forceinline__ void a_ready(const Unit&) const {}
    __device__ __forceinline__ void done(const Unit&) const {}
};

struct LoraOrder {
    int c;
    __device__ __forceinline__ bool next(int i, Unit& u) const {
        if (c < 128) { if (i == 0) { u.pm = c >> 2; u.pn = c & 3; return true; } return false; }
        if (i < 2) { const int k = 2 * (c - 128) + i; u.pm = k >> 3; u.pn = 4 + (k & 7); return true; } return false; }
    __device__ __forceinline__ void a_ready(const Unit&) const {}
    __device__ __forceinline__ void done(const Unit&) const {}
};
struct SubOrder {
    int nM, nNb, pn0, NGb, c;
    __device__ __forceinline__ bool next(int i, Unit& u) const { const int L = i * NGb + c; if (L >= nM * nNb) return false; u.pm = L % nM; u.pn = pn0 + L / nM; return true; }
    __device__ __forceinline__ void a_ready(const Unit&) const {}
    __device__ __forceinline__ void done(const Unit&) const {}
};

typedef float f32x2c_t __attribute__((ext_vector_type(2))); typedef __bf16 bf16x2c_t __attribute__((ext_vector_type(2)));
__device__ __forceinline__ unsigned cvt_pk_bf16(float lo, float hi) { f32x2c_t v = {lo, hi}; bf16x2c_t b = __builtin_convertvector(v, bf16x2c_t); return __builtin_bit_cast(unsigned, b); }
typedef float f32x2 __attribute__((ext_vector_type(2)));
__device__ __forceinline__ f32x2 gelu_pk(f32x2 v) {
    const f32x2 av = __builtin_elementwise_abs(v), d = av * 0.2316418882f + 1.0f;
    f32x2 t; t.x = __builtin_amdgcn_rcpf(d.x); t.y = __builtin_amdgcn_rcpf(d.y);
    f32x2 q = t * 0.5307027145f + (-0.7265760135f); q = q * t + 0.7107068705f; q = q * t + (-0.142248368f); q = q * t + 0.127414796f; q = q * t;
    const f32x2 s = (v * v) * (-0.72134752044f);
    f32x2 e; e.x = __builtin_amdgcn_exp2f(s.x); e.y = __builtin_amdgcn_exp2f(s.y);
    const f32x2 m = v * (q * e), r = v - m;
    f32x2 o; o.x = v.x < 0.f ? m.x : r.x; o.y = v.y < 0.f ? m.y : r.y; return o;
}


__device__ __forceinline__ float fast_sigmoid(float v) { return __builtin_amdgcn_rcpf(1.0f + __expf(-v)); }
__device__ __forceinline__ u32x4 pack8(const f32x4 v0, const f32x4 v1) { u32x4 w; w.x = cvt_pk_bf16(v0[0], v0[1]); w.y = cvt_pk_bf16(v0[2], v0[3]); w.z = cvt_pk_bf16(v1[0], v1[1]); w.w = cvt_pk_bf16(v1[2], v1[3]); return w; }
__device__ __forceinline__ void unpack8(const u32x4 w, f32x4& v0, f32x4& v1) {
    v0[0] = __uint_as_float(w.x << 16); v0[1] = __uint_as_float(w.x & 0xffff0000u); v0[2] = __uint_as_float(w.y << 16); v0[3] = __uint_as_float(w.y & 0xffff0000u);
    v1[0] = __uint_as_float(w.z << 16); v1[1] = __uint_as_float(w.z & 0xffff0000u); v1[2] = __uint_as_float(w.w << 16); v1[3] = __uint_as_float(w.w & 0xffff0000u); }

struct EpiZ {
    static constexpr bool PERM = true, AFTER_DRAIN = false;
    bf16_t *Qb, *Kb, *Vr, *Gb, *Zr, *SG; const float* rcos; const float* rsin; const float* SA; const unsigned* SBM;
    static __device__ __forceinline__ f32x4 deq(const f32x4 a, const float sa, const f32x4 sb) { const i32x4 i = __builtin_bit_cast(i32x4, a); return (f32x4){(float)i[0] * sa * sb[0], (float)i[1] * sa * sb[1], (float)i[2] * sa * sb[2], (float)i[3] * sa * sb[3]}; }
    template <int ACT> __device__ __forceinline__ void plain(const f32x4 (&acc)[2][2][4][2], bf16_t* O, int ldc, int row0, int cl, const f32x4 (&sb)[2][2]) const {
#pragma unroll
        for (int ai = 0; ai < 2; ++ai)
#pragma unroll
            for (int m = 0; m < 4; ++m) { bf16_t* rowp = O + (size_t)(row0 + ai * HALF + m * 16) * ldc + cl; const float sa = SA[row0 + ai * HALF + m * 16];
#pragma unroll
                for (int bj = 0; bj < 2; ++bj) { f32x4 v0 = deq(acc[ai][bj][m][0], sa, sb[bj][0]), v1 = deq(acc[ai][bj][m][1], sa, sb[bj][1]);
                    if (ACT == 1) {
#pragma unroll
                        for (int j = 0; j < 4; ++j) { v0[j] = v0[j] * fast_sigmoid(v0[j]); v1[j] = v1[j] * fast_sigmoid(v1[j]); } }
                    if (ACT == 2) {
#pragma unroll
                        for (int j = 0; j < 4; ++j) { v0[j] = fast_sigmoid(v0[j]); v1[j] = fast_sigmoid(v1[j]); } }
                    *(u32x4*)(rowp + bj * HALF) = pack8(v0, v1); } }
    }
    __device__ __forceinline__ void operator()(const f32x4 (&acc)[2][2][4][2], const Unit& u, int wr, int wc, int fr, int fq) const {
        const int pn = u.pn, row0 = u.pm * BM + wr * 64 + fr, cl = wc * 32 + 8 * fq;
        f32x4 sb[2][2];
#pragma unroll
        for (int bj = 0; bj < 2; ++bj)
#pragma unroll
            for (int hh = 0; hh < 2; ++hh) { const u32x4 t = *(const u32x4*)(SBM + pn * 256 + cl + bj * HALF + 4 * hh);
                sb[bj][hh] = (f32x4){__uint_as_float(t.x), __uint_as_float(t.y), __uint_as_float(t.z), __uint_as_float(t.w)} * (1.0f / 127.0f); }
        if (pn < 8) {
            bf16_t* O = (pn < 4 ? Qb : Kb) + (pn & 3) * 256; const float sc = pn < 4 ? 1.0f : 0.0625f;
#pragma unroll
            for (int ai = 0; ai < 2; ++ai)
#pragma unroll
                for (int m = 0; m < 4; ++m) { const int row = row0 + ai * HALF + m * 16, pos = row & 4095;
                    const float* cp = rcos + pos * 128 + cl; const float* sp = rsin + pos * 128 + cl;
                    const f32x4 c0 = *(const f32x4*)cp, c1 = *(const f32x4*)(cp + 4), s0 = *(const f32x4*)sp, s1 = *(const f32x4*)(sp + 4);
                    const float sa = SA[row];
                    const f32x4 z1a = deq(acc[ai][0][m][0], sa, sb[0][0]), z1b = deq(acc[ai][0][m][1], sa, sb[0][1]), z2a = deq(acc[ai][1][m][0], sa, sb[1][0]), z2b = deq(acc[ai][1][m][1], sa, sb[1][1]);
                    const f32x4 o1a = (z1a * c0 - z2a * s0) * sc, o1b = (z1b * c1 - z2b * s1) * sc, o2a = (z2a * c0 + z1a * s0) * sc, o2b = (z2b * c1 + z1b * s1) * sc;
                    bf16_t* rowp = O + (size_t)row * 1024 + cl;
                    *(u32x4*)(rowp) = pack8(o1a, o1b); *(u32x4*)(rowp + HALF) = pack8(o2a, o2b); }
        } else if (pn < 12) plain<0>(acc, Vr + (pn - 8) * 256, 1024, row0, cl, sb);
        else if (pn < 16) plain<1>(acc, Gb + (pn - 12) * 256, 1024, row0, cl, sb);
        else if (pn < 29) plain<0>(acc, Zr + (pn - 16) * 256, 3328, row0, cl, sb);
        else {
            unsigned char* O8 = (unsigned char*)SG + (pn - 29) * 256;
#pragma unroll
            for (int ai = 0; ai < 2; ++ai)
#pragma unroll
                for (int m = 0; m < 4; ++m) { unsigned char* rowp = O8 + (size_t)(row0 + ai * HALF + m * 16) * 4096 + cl; const float sa = SA[row0 + ai * HALF + m * 16];
#pragma unroll
                    for (int bj = 0; bj < 2; ++bj) { const f32x4 v0 = deq(acc[ai][bj][m][0], sa, sb[bj][0]), v1 = deq(acc[ai][bj][m][1], sa, sb[bj][1]); unsigned w0 = 0, w1 = 0;
#pragma unroll
                        for (int j = 0; j < 4; ++j) { w0 |= (unsigned)__builtin_rintf(255.0f * fast_sigmoid(v0[j])) << (8 * j); w1 |= (unsigned)__builtin_rintf(255.0f * fast_sigmoid(v1[j])) << (8 * j); }
                        typedef unsigned u32x2_t __attribute__((ext_vector_type(2))); *(u32x2_t*)(rowp + bj * HALF) = (u32x2_t){w0, w1}; } } }
    }
};
struct EpiLora {
    static constexpr bool PERM = true, AFTER_DRAIN = false;
    float* DEC; bf16_t* Ab; bf16_t* Gg; const float* w0; const float* a0;
    __device__ __forceinline__ void operator()(const f32x4 (&acc)[2][2][4][2], const Unit& u, int wr, int wc, int fr, int fq) const {
        const int pn = u.pn, row0 = u.pm * BM + wr * 64 + fr, cl = wc * 32 + 8 * fq;
        if (pn < 4) {
            const int cb = pn * 256 + cl;
#pragma unroll
            for (int ai = 0; ai < 2; ++ai)
#pragma unroll
                for (int m = 0; m < 4; ++m) {
#pragma unroll
                    for (int bj = 0; bj < 2; ++bj) { const f32x4 b0 = *(const f32x4*)(w0 + cb + bj * HALF), b1 = *(const f32x4*)(w0 + cb + bj * HALF + 4);
                        f32x4 v0 = acc[ai][bj][m][0] + b0, v1 = acc[ai][bj][m][1] + b1;
#pragma unroll
                        for (int j = 0; j < 4; ++j) {
                            v0[j] = __expf(-0.60653065971263342f * fast_sigmoid(v0[j])); v1[j] = __expf(-0.60653065971263342f * fast_sigmoid(v1[j])); }
                        float* rowp = DEC + (size_t)(row0 + ai * HALF + m * 16) * 1024 + cb + bj * HALF;
                        *(f32x4*)rowp = v0; *(f32x4*)(rowp + 4) = v1; asm volatile("" ::: "memory"); } }
        } else if (pn < 8) {
            const int cb = (pn - 4) * 256 + cl;
#pragma unroll
            for (int bj = 0; bj < 2; ++bj) { const f32x4 b0 = *(const f32x4*)(a0 + cb + bj * HALF), b1 = *(const f32x4*)(a0 + cb + bj * HALF + 4);
#pragma unroll
                for (int ai = 0; ai < 2; ++ai)
#pragma unroll
                    for (int m = 0; m < 4; ++m) { f32x4 v0 = acc[ai][bj][m][0] + b0, v1 = acc[ai][bj][m][1] + b1;
#pragma unroll
                        for (int j = 0; j < 4; ++j) { v0[j] = fast_sigmoid(v0[j]); v1[j] = fast_sigmoid(v1[j]); }
                        *(u32x4*)(Ab + (size_t)(row0 + ai * HALF + m * 16) * 1024 + cb + bj * HALF) = pack8(v0, v1); asm volatile("" ::: "memory"); } }
        } else {
            const int cb = (pn - 8) * 256 + cl;
#pragma unroll
            for (int ai = 0; ai < 2; ++ai)
#pragma unroll
                for (int m = 0; m < 4; ++m)
#pragma unroll
                    for (int bj = 0; bj < 2; ++bj) *(u32x4*)(Gg + (size_t)(row0 + ai * HALF + m * 16) * 1024 + cb + bj * HALF) = pack8(acc[ai][bj][m][0], acc[ai][bj][m][1]);
        }
    }
};
template <int MODE> struct EpiGen {
    static constexpr bool PERM = true, AFTER_DRAIN = false;
    const bf16_t* SG; int goff; float* F; bf16_t* O; const float* xres; int ldo; const float* SA = nullptr; const unsigned* SBM = nullptr;
    __device__ __forceinline__ void operator()(const f32x4 (&acc)[2][2][4][2], const Unit& u, int wr, int wc, int fr, int fq) const {
        const int row0 = u.pm * BM + wr * 64 + fr, col0 = u.pn * BM + wc * 32 + 8 * fq;

#pragma unroll
        for (int ai = 0; ai < 2; ++ai)
#pragma unroll
            for (int m = 0; m < 4; ++m) { const size_t row = (size_t)(row0 + ai * HALF + m * 16);
#pragma unroll
                for (int bj = 0; bj < 2; ++bj) { const int col = col0 + bj * HALF; f32x4 v0 = acc[ai][bj][m][0], v1 = acc[ai][bj][m][1];
                    if (MODE == 0 || MODE == 1) { const float sa = SA[row] * (1.0f / 127.0f); const u32x4 t0 = *(const u32x4*)(SBM + col), t1 = *(const u32x4*)(SBM + col + 4);
                        v0 = EpiZ::deq(v0, sa, (f32x4){__uint_as_float(t0.x), __uint_as_float(t0.y), __uint_as_float(t0.z), __uint_as_float(t0.w)}); v1 = EpiZ::deq(v1, sa, (f32x4){__uint_as_float(t1.x), __uint_as_float(t1.y), __uint_as_float(t1.z), __uint_as_float(t1.w)}); }
                    if (MODE == 0 || MODE == 1) { typedef unsigned u32x2_t __attribute__((ext_vector_type(2))); const u32x2_t gq = *(const u32x2_t*)((const unsigned char*)SG + row * 4096 + goff + col);
                        const f32x4 g0 = (f32x4){(float)(gq.x & 0xffu), (float)((gq.x >> 8) & 0xffu), (float)((gq.x >> 16) & 0xffu), (float)(gq.x >> 24)} * (1.0f / 255.0f), g1 = (f32x4){(float)(gq.y & 0xffu), (float)((gq.y >> 8) & 0xffu), (float)((gq.y >> 16) & 0xffu), (float)(gq.y >> 24)} * (1.0f / 255.0f);
                        v0 = v0 * g0; v1 = v1 * g1; }
                    if (MODE == 0) { *(u32x4*)((bf16_t*)F + row * 2048 + col) = pack8(v0, v1); }
                    if (MODE == 1) { f32x4 p0, p1; unpack8(*(const u32x4*)((const bf16_t*)F + row * 2048 + col), p0, p1); v0 = v0 + p0; v1 = v1 + p1; *(u32x4*)(O + row * 2048 + col) = pack8(v0, v1); }
                    if (MODE == 2) { const float* p = xres + row * 2048 + col; v0 = v0 + *(const f32x4*)p; v1 = v1 + *(const f32x4*)(p + 4); float* q = F + row * 2048 + col; *(f32x4*)q = v0; *(f32x4*)(q + 4) = v1; }
                    if (MODE == 3) { *(u32x4*)(O + row * (size_t)ldo + col) = pack8(v0, v1); }
                    if (MODE == 4) { float* q = F + row * (size_t)ldo + col; *(f32x4*)q = v0; *(f32x4*)(q + 4) = v1; }
                    if (MODE == 5) { *(u32x4*)(O + ((size_t)(col >> 11) * 256 + row) * 2048 + (col & 2047)) = pack8(v0, v1); } }
                asm volatile("" ::: "memory"); }
    }
};
struct EpiX1 {
    static constexpr bool PERM = true, AFTER_DRAIN = false;
    const float* xres; bf16_t* X1; bf16_t* XW; const float* nw; float* PART;
    __device__ __forceinline__ void operator()(const f32x4 (&acc)[2][2][4][2], const Unit& u, int wr, int wc, int fr, int fq) const {
        const int row0 = u.pm * BM + wr * 64 + fr, col0 = u.pn * BM + wc * 32 + 8 * fq;
#pragma unroll
        for (int ai = 0; ai < 2; ++ai)
#pragma unroll
            for (int m = 0; m < 4; ++m) { const size_t row = (size_t)(row0 + ai * HALF + m * 16); float ss = 0.f;
#pragma unroll
                for (int bj = 0; bj < 2; ++bj) { const int col = col0 + bj * HALF; const float* p = xres + row * 2048 + col;
                    const f32x4 v0 = acc[ai][bj][m][0] + *(const f32x4*)p, v1 = acc[ai][bj][m][1] + *(const f32x4*)(p + 4);
                    *(u32x4*)(X1 + row * 2048 + col) = pack8(v0, v1);
                    ss += (v0[0] * v0[0] + v0[1] * v0[1]) + (v0[2] * v0[2] + v0[3] * v0[3]) + (v1[0] * v1[0] + v1[1] * v1[1]) + (v1[2] * v1[2] + v1[3] * v1[3]);
 }
                ss += __shfl_xor(ss, 16); ss += __shfl_xor(ss, 32);
                if (fq == 0) PART[row * 32 + u.pn * 4 + wc] = ss;
                asm volatile("" ::: "memory"); }
    }
};
struct EpiScore {
    static constexpr bool PERM = true, AFTER_DRAIN = false;
    float* C; const PG8_LAS float* rstd;
    __device__ __forceinline__ void operator()(const f32x4 (&acc)[2][2][4][2], const Unit& u, int wr, int wc, int fr, int fq) const {
        const int rl0 = wr * 64 + fr, col0 = u.pn * BM + wc * 32 + 8 * fq;
#pragma unroll
        for (int ai = 0; ai < 2; ++ai)
#pragma unroll
            for (int m = 0; m < 4; ++m) { const int rl = rl0 + ai * HALF + m * 16; const float r = rstd[rl]; const size_t row = (size_t)(u.pm * BM + rl);
#pragma unroll
                for (int bj = 0; bj < 2; ++bj) { float* q = C + row * 2048 + col0 + bj * HALF; *(f32x4*)q = acc[ai][bj][m][0] * r; *(f32x4*)(q + 4) = acc[ai][bj][m][1] * r; }
                asm volatile("" ::: "memory"); }
    }
};
template <class Epi, class Sched, bool ALIGN_EPI = false, bool SP2 = false, bool I8 = false>
__device__ __forceinline__ void gemm_phase(PG8_LAS unsigned char* lds, const Gemm g, const Sched& S, const Epi& E) {
    const int tid = threadIdx.x, wid = __builtin_amdgcn_readfirstlane(tid >> 6), lane = tid & 63, wr = wid >> 2, wc = wid & 3, fr = lane & 15, fq = lane >> 4;
    const int K = g.K, nt = K / BK;
    unsigned voffA[2], voffB[2];
#pragma unroll
    for (int i = 0; i < 2; ++i) { int R, C; stage_rc(tid * 16 + i * 8192, R, C); const int Rb = Epi::PERM ? ((R & ~31) + perm32(R & 31)) : R;
        voffA[i] = (unsigned)(R * K + C) * 2u; voffB[i] = (unsigned)(Rb * K + C) * 2u; }
    const size_t kstep = (size_t)(BK * 2);
    const size_t hstep = (size_t)HALF * K * 2;
    const size_t tstep = 2 * hstep;
    const unsigned ldsw = (unsigned)wid * 1024u;
    const int aoff = lds_byte(wr * 64 + fr, fq * 8), boff = lds_byte(wc * 32 + fr, fq * 8);
#define PG8_SA(b, h) (((b) * 2 + (h)) * HTB)
#define PG8_SB(b, h) ((4 + (b) * 2 + (h)) * HTB)
#define PG8_STAGE(bufoff, gbase, voff) do { _Pragma("unroll") for (int _i = 0; _i < 2; ++_i) \
        __builtin_amdgcn_global_load_lds((const unsigned*)((const char*)(gbase) + (voff)[_i]), (PG8_LAS unsigned*)(lds + (bufoff) + ldsw + _i * 8192), 16, 0, 0); } while (0)
#define PG8_LDA(dst, b, h) do { _Pragma("unroll") for (int m = 0; m < 4; ++m) _Pragma("unroll") for (int k = 0; k < 2; ++k) dst[m][k] = *(const PG8_LAS bf16x8*)(lds + PG8_SA(b, h) + aoff + m * 2048 + k * 1024); } while (0)
#define PG8_LDB(dst, b, h) do { _Pragma("unroll") for (int n = 0; n < 2; ++n) _Pragma("unroll") for (int k = 0; k < 2; ++k) dst[n][k] = *(const PG8_LAS bf16x8*)(lds + PG8_SB(b, h) + boff + n * 2048 + k * 1024); } while (0)
#define PG8_MMA(ai, bj, At, Bt) do { __builtin_amdgcn_s_setprio(1); _Pragma("unroll") for (int m = 0; m < 4; ++m) _Pragma("unroll") for (int n = 0; n < 2; ++n) _Pragma("unroll") for (int k = 0; k < 2; ++k) { \
        if (I8) acc[ai][bj][m][n] = __builtin_bit_cast(f32x4, __builtin_amdgcn_mfma_i32_16x16x64_i8(__builtin_bit_cast(i32x4, Bt[n][k]), __builtin_bit_cast(i32x4, At[m][k]), __builtin_bit_cast(i32x4, acc[ai][bj][m][n]), 0, 0, 0)); \
        else acc[ai][bj][m][n] = __builtin_amdgcn_mfma_f32_16x16x32_bf16(Bt[n][k], At[m][k], acc[ai][bj][m][n], 0, 0, 0); } __builtin_amdgcn_s_setprio(0); } while (0)
#define PG8_WAIT_V(n) asm volatile("s_waitcnt vmcnt(" #n ")" ::: "memory")
#define PG8_WAIT_L(n) asm volatile("s_waitcnt lgkmcnt(" #n ")" ::: "memory")
#define PG8_BAR __builtin_amdgcn_s_barrier()
#define PG8_SCHED __builtin_amdgcn_sched_barrier(0)
    Unit cur, nxt; int ui = 0;
    if (!S.next(0, cur)) return;
    f32x4 acc[2][2][4][2];
#pragma unroll
    for (int a = 0; a < 2; ++a)
#pragma unroll
        for (int b = 0; b < 2; ++b)
#pragma unroll
            for (int m = 0; m < 4; ++m)
#pragma unroll
                for (int n = 0; n < 2; ++n) acc[a][b][m][n] = (f32x4){0.f, 0.f, 0.f, 0.f};
    bf16x8 At[4][2], B0[2][2], B1[2][2];
    const char* cA = (const char*)g.A + (size_t)cur.pm * tstep; const char* cB = (const char*)g.Bt + (size_t)cur.pn * tstep;
    S.a_ready(cur);
    if constexpr (SP2) {
        PG8_STAGE(PG8_SB(0, 0), cB, voffB); PG8_STAGE(PG8_SB(0, 1), cB + hstep, voffB); PG8_STAGE(PG8_SA(0, 0), cA, voffA); PG8_STAGE(PG8_SA(0, 1), cA + hstep, voffA);
        if (wr == 1) PG8_BAR;
        PG8_WAIT_V(2); PG8_BAR;
        PG8_STAGE(PG8_SB(1, 0), cB + kstep, voffB); PG8_STAGE(PG8_SA(1, 0), cA + kstep, voffA); PG8_STAGE(PG8_SB(1, 1), cB + hstep + kstep, voffB);
        PG8_WAIT_V(6); PG8_BAR;
    } else {
        PG8_STAGE(PG8_SB(0, 0), cB, voffB); PG8_STAGE(PG8_SA(0, 0), cA, voffA); PG8_STAGE(PG8_SB(0, 1), cB + hstep, voffB); PG8_STAGE(PG8_SA(0, 1), cA + hstep, voffA);
        if (wr == 1) PG8_BAR;
        PG8_WAIT_V(4); PG8_BAR;
        PG8_STAGE(PG8_SB(1, 0), cB + kstep, voffB); PG8_STAGE(PG8_SA(1, 0), cA + kstep, voffA); PG8_STAGE(PG8_SB(1, 1), cB + hstep + kstep, voffB);
        PG8_WAIT_V(6); PG8_BAR;
    }
    for (;;) {
        const bool has_next = S.next(ui + 1, nxt);
        const char* nA = has_next ? (const char*)g.A + (size_t)nxt.pm * tstep : cA; const char* nB = has_next ? (const char*)g.Bt + (size_t)nxt.pn * tstep : cB;
        for (int t = 0; t < nt; t += 2) {
            const bool last = (t == nt - 2);
            const char* a1 = cA + (size_t)(t + 1) * kstep;
            const char* a2 = last ? nA : cA + (size_t)(t + 2) * kstep; const char* b2 = last ? nB : cB + (size_t)(t + 2) * kstep;
            const char* a3 = a2 + kstep; const char* b3 = b2 + kstep;
            if (last && has_next) S.a_ready(nxt);
            if constexpr (SP2) {
            PG8_LDB(B0, 0, 0); PG8_LDB(B1, 0, 1); PG8_SCHED; PG8_LDA(At, 0, 0); PG8_STAGE(PG8_SA(1, 1), a1 + hstep, voffA);
            PG8_WAIT_V(8); PG8_WAIT_L(0); PG8_BAR; PG8_MMA(0, 0, At, B0); PG8_MMA(0, 1, At, B1); PG8_BAR; PG8_SCHED;
            PG8_LDA(At, 0, 1); PG8_STAGE(PG8_SB(0, 0), b2, voffB); PG8_STAGE(PG8_SB(0, 1), b2 + hstep, voffB); PG8_STAGE(PG8_SA(0, 0), a2, voffA);
            PG8_WAIT_V(8); PG8_WAIT_L(0); PG8_BAR; PG8_MMA(1, 0, At, B0); PG8_MMA(1, 1, At, B1); PG8_BAR; PG8_SCHED;
            PG8_LDB(B0, 1, 0); PG8_LDB(B1, 1, 1); PG8_SCHED; PG8_LDA(At, 1, 0); PG8_STAGE(PG8_SA(0, 1), a2 + hstep, voffA);
            PG8_WAIT_V(8); PG8_WAIT_L(0); PG8_BAR; PG8_MMA(0, 0, At, B0); PG8_MMA(0, 1, At, B1); PG8_BAR; PG8_SCHED;
            PG8_LDA(At, 1, 1); PG8_STAGE(PG8_SB(1, 0), b3, voffB); PG8_STAGE(PG8_SB(1, 1), b3 + hstep, voffB); PG8_STAGE(PG8_SA(1, 0), a3, voffA);
            PG8_WAIT_V(8); PG8_WAIT_L(0); PG8_BAR; PG8_MMA(1, 0, At, B0); PG8_MMA(1, 1, At, B1); PG8_BAR; PG8_SCHED;
            } else {
            PG8_LDB(B0, 0, 0); PG8_SCHED; PG8_LDA(At, 0, 0); PG8_STAGE(PG8_SA(1, 1), a1 + hstep, voffA);
            PG8_WAIT_L(8); PG8_BAR; PG8_WAIT_L(0); PG8_MMA(0, 0, At, B0); PG8_BAR; PG8_SCHED;
            PG8_LDB(B1, 0, 1); PG8_STAGE(PG8_SB(0, 0), b2, voffB);
            PG8_BAR; PG8_WAIT_L(0); PG8_MMA(0, 1, At, B1); PG8_BAR;
            PG8_LDA(At, 0, 1); PG8_STAGE(PG8_SA(0, 0), a2, voffA);
            PG8_BAR; PG8_WAIT_L(0); PG8_MMA(1, 0, At, B0); PG8_BAR; PG8_SCHED;
            PG8_STAGE(PG8_SB(0, 1), b2 + hstep, voffB);
            PG8_WAIT_V(6); PG8_BAR; PG8_MMA(1, 1, At, B1); PG8_BAR;
            PG8_LDB(B0, 1, 0); PG8_SCHED; PG8_LDA(At, 1, 0); PG8_STAGE(PG8_SA(0, 1), a2 + hstep, voffA);
            PG8_WAIT_L(8); PG8_BAR; PG8_WAIT_L(0); PG8_MMA(0, 0, At, B0); PG8_BAR; PG8_SCHED;
            PG8_LDB(B1, 1, 1); PG8_STAGE(PG8_SB(1, 0), b3, voffB);
            PG8_BAR; PG8_WAIT_L(0); PG8_MMA(0, 1, At, B1); PG8_BAR;
            PG8_LDA(At, 1, 1); PG8_STAGE(PG8_SA(1, 0), a3, voffA);
            PG8_BAR; PG8_WAIT_L(0); PG8_MMA(1, 0, At, B0); PG8_BAR; PG8_SCHED;
            PG8_STAGE(PG8_SB(1, 1), b3 + hstep, voffB);
            PG8_WAIT_V(6); PG8_BAR; PG8_MMA(1, 1, At, B1); PG8_BAR;
            }
        }
        if constexpr (ALIGN_EPI) { if (wr == 0) PG8_BAR; }
        if constexpr (!Epi::AFTER_DRAIN) { E(acc, cur, wr, wc, fr, fq); S.done(cur); }
        if (!has_next) break;
#pragma unroll
        for (int a = 0; a < 2; ++a)
#pragma unroll
            for (int b = 0; b < 2; ++b)
#pragma unroll
                for (int m = 0; m < 4; ++m)
#pragma unroll
                    for (int n = 0; n < 2; ++n) acc[a][b][m][n] = (f32x4){0.f, 0.f, 0.f, 0.f};
        cur = nxt; cA = nA; cB = nB; ++ui;
        if constexpr (ALIGN_EPI) { if (wr == 1) PG8_BAR; }
    }
    PG8_WAIT_V(0);
    if constexpr (!ALIGN_EPI) { if (wr == 0) PG8_BAR; }
    PG8_BAR;
    if constexpr (Epi::AFTER_DRAIN) { E.fused(acc, cur, wr, wc, fr, fq, lds, wid, lane); S.done(cur); }
#undef PG8_SA
#undef PG8_SB
#undef PG8_STAGE
#undef PG8_LDA
#undef PG8_LDB
#undef PG8_MMA
#undef PG8_WAIT_V
#undef PG8_WAIT_L
#undef PG8_BAR
#undef PG8_SCHED
}
}

constexpr int NWAVES = 8, NTHR = 512;
constexpr int NTOK = 8192, SEQ = 4096, DM = 2048, IN_COLS = 11520, RW = 1024, ZRC = 3328;
constexpr size_t MiB = 1u << 20;
constexpr size_t WS_CTL = 0, CTL_ZERO_BYTES = 128 * 1024;
constexpr size_t WS_SBRW = 112 * 1024;
constexpr size_t WS_SAR = 490 * MiB + 64 * 1024, WS_SAW = 490 * MiB + 128 * 1024;
constexpr size_t WS_X1B = 430 * MiB;
constexpr size_t WS_SBM = 64 * 1024, WS_SA = 490 * MiB;
constexpr size_t WS_KEYS = 1 * MiB;
constexpr size_t WS_WLORA = 2 * MiB;
constexpr size_t WS_ROT = 4 * MiB;
constexpr size_t WS_WR = 8 * MiB, WS_WW = 12 * MiB, WS_WO = 16 * MiB, WS_WQ = 24 * MiB;
constexpr size_t WS_GB = 32 * MiB;
constexpr size_t WS_SG = 48 * MiB;
constexpr size_t WS_QB = 112 * MiB, WS_KB = 128 * MiB;
constexpr size_t WS_KT = 144 * MiB, WS_VT = 160 * MiB, WS_VDT = 176 * MiB;
constexpr size_t WS_RKV = 192 * MiB;
constexpr size_t WS_DEC = 240 * MiB;
constexpr size_t WS_AB = 272 * MiB, WS_GG = 288 * MiB;
constexpr size_t WS_Y = 304 * MiB;
constexpr size_t WS_ORET = 336 * MiB;
constexpr size_t WS_VR = 352 * MiB;
constexpr size_t WS_WIN = 368 * MiB;
constexpr size_t WS_ZR = 413 * MiB;
constexpr size_t WS_H = 465 * MiB;
constexpr size_t WS_L = 368 * MiB;
constexpr size_t WS_U8 = 368 * MiB, WS_V8 = 413 * MiB, WS_SCU = 490 * MiB + 256 * 1024, WS_SCV = 490 * MiB + 320 * 1024;
constexpr size_t WS_KV = 448 * MiB;
constexpr int CW_GBAR = 8192;
constexpr size_t WS_UB = 368 * MiB, WS_VB = 432 * MiB;
constexpr size_t WS_ORN = 144 * MiB, WS_OWN = 160 * MiB;
constexpr size_t WS_M1 = 430 * MiB;
constexpr size_t WS_MG = 256 * MiB;
constexpr size_t WS_H2 = 112 * MiB;
constexpr size_t WS_QP = 144 * MiB;
constexpr size_t WS_SC = 192 * MiB;
constexpr size_t WS_H2Q = 256 * MiB, WS_SX = 272 * MiB;
constexpr size_t WS_PART = 354 * MiB;
constexpr size_t WS_WQK = 356 * MiB;
constexpr size_t WS_END = 512 * MiB;

constexpr int RING_BYTES = 131072, LDSCTL_OFF = RING_BYTES, MISC_OFF = LDSCTL_OFF + 320, LDS_BYTES = 147456;
constexpr int CW_BAR = 4096;

#define GAS __attribute__((address_space(1)))
#define LAS __attribute__((address_space(3)))
typedef unsigned short bf16;
typedef unsigned v4u __attribute__((ext_vector_type(4)));
typedef unsigned v2u __attribute__((ext_vector_type(2)));
typedef float f32x4 __attribute__((ext_vector_type(4)));
typedef short bf16x8 __attribute__((ext_vector_type(8)));
typedef __bf16 bf16x2v __attribute__((ext_vector_type(2)));
typedef GAS unsigned gu32;
#define LDS_WAIT() asm volatile("s_waitcnt lgkmcnt(0)" ::: "memory")
#define VM_WAIT() asm volatile("s_waitcnt vmcnt(0)" ::: "memory")
__device__ __forceinline__ unsigned f2bf(float f) { unsigned u = __builtin_bit_cast(unsigned, f); return (u + 0x7fffu + ((u >> 16) & 1u)) >> 16; }
__device__ __forceinline__ unsigned pk2(float lo, float hi) { return f2bf(lo) | (f2bf(hi) << 16); }
__device__ __forceinline__ float bflo(unsigned u) { return __uint_as_float(u << 16); }
__device__ __forceinline__ float bfhi(unsigned u) { return __uint_as_float(u & 0xffff0000u); }
__device__ __forceinline__ float bf1(bf16 b) { return __uint_as_float(((unsigned)b) << 16); }
__device__ __forceinline__ float sigm(float v) { return 1.0f / (1.0f + __expf(-v)); }
template <int CTRL> __device__ __forceinline__ float dppf(float x) { return __builtin_bit_cast(float, __builtin_amdgcn_update_dpp(0, __builtin_bit_cast(int, x), CTRL, 0xf, 0xf, false)); }
template <int CTRL> __device__ __forceinline__ int dppi(int x) { return __builtin_amdgcn_update_dpp(0, x, CTRL, 0xf, 0xf, false); }
__device__ __forceinline__ float rowsum16(float x) { x += dppf<0x128>(x); x += dppf<0x124>(x); x += dppf<0x122>(x); x += dppf<0x121>(x); return x; }
__device__ __forceinline__ float rowmax16(float x) { x = fmaxf(x, dppf<0x128>(x)); x = fmaxf(x, dppf<0x124>(x)); x = fmaxf(x, dppf<0x122>(x)); x = fmaxf(x, dppf<0x121>(x)); return x; }
__device__ __forceinline__ float quadsum(float x) { x += dppf<0xB1>(x); x += dppf<0x4E>(x); return x; }
__device__ __forceinline__ float wave_sum(float v) { v = rowsum16(v); v += __shfl_xor(v, 16); v += __shfl_xor(v, 32); return v; }
__device__ __forceinline__ float wave_max(float v) { v = rowmax16(v); v = fmaxf(v, __shfl_xor(v, 16)); v = fmaxf(v, __shfl_xor(v, 32)); return v; }
__device__ __forceinline__ float dot2bf(unsigned w, unsigned x, float acc) { return __builtin_amdgcn_fdot2_f32_bf16(__builtin_bit_cast(bf16x2v, w), __builtin_bit_cast(bf16x2v, x), acc, false); }
__device__ __forceinline__ f32x4 mfma16(bf16x8 a, bf16x8 b, f32x4 c) { return __builtin_amdgcn_mfma_f32_16x16x32_bf16(a, b, c, 0, 0, 0); }
__device__ __forceinline__ float gelu_erf(float v) {
    const float av = fabsf(v), t = __builtin_amdgcn_rcpf(av * 0.2316418882f + 1.0f);
    float q = t * 0.5307027145f + (-0.7265760135f); q = q * t + 0.7107068705f; q = q * t + (-0.142248368f); q = q * t + 0.127414796f; q = q * t;
    const float e = __builtin_amdgcn_exp2f((v * v) * (-0.72134752044f)); const float m = v * (q * e);
    return v < 0.f ? m : v - m;
}

#define XB_TMO      128
#define XB_XCNT(j)  (256  + 64 * (j))
#define XB_XSUB(j)  (1280 + 64 * (j))
#define XB_XGEN(j)  (2304 + 64 * (j))
#define XB_TOP      3328
#define XB_TOPGEN   3392
#define XCD_BAR_WORDS 3456
#define XB_SPIN_CAP (1u << 18)

__device__ __forceinline__ unsigned xb_ld(unsigned* p)              { return __hip_atomic_load(p, __ATOMIC_RELAXED, __HIP_MEMORY_SCOPE_AGENT); }
__device__ __forceinline__ unsigned xb_add(unsigned* p, unsigned v) { return __hip_atomic_fetch_add(p, v, __ATOMIC_RELAXED, __HIP_MEMORY_SCOPE_AGENT); }
__device__ __forceinline__ unsigned xb_xcc_id() { return (unsigned)__builtin_amdgcn_s_getreg((3 << 11) | 20) & 0xFu; }
#define XB_SPIN(cond, bar) do { unsigned _sp = 0; while (cond) { __builtin_amdgcn_s_sleep(1); \
    if ((++_sp & 255u) == 0u) { if (xb_ld(&(bar)[XB_TMO])) break; if (_sp > XB_SPIN_CAP) { atomicAdd(&(bar)[XB_TMO], 1u); break; } } } } while (0)

struct XcdBarrier {
    unsigned* bar; unsigned x;
    volatile LAS unsigned* st;
};

__device__ __forceinline__ XcdBarrier xcd_barrier_post(unsigned* bar, volatile LAS unsigned* st) {
    XcdBarrier b; b.bar = bar; b.x = xb_xcc_id(); b.st = st;
    if (threadIdx.x == 0) (void)xb_add(&bar[XB_XCNT(b.x)], 1u);
    return b;
}
__device__ __forceinline__ void xcd_barrier_complete(unsigned* bar, unsigned x, unsigned& nloc, unsigned& nx) {
    const unsigned G = gridDim.x * gridDim.y * gridDim.z;
    unsigned sum, cnt, mine, sp = 0u;
    for (;;) {
        sum = 0u; cnt = 0u; mine = 0u;
#pragma unroll
        for (unsigned j = 0; j < 16; ++j) { const unsigned c = xb_ld(&bar[XB_XCNT(j)]); sum += c; cnt += (c > 0u) ? 1u : 0u; mine = (j == x) ? c : mine; }
        if (sum == G) break;
        __builtin_amdgcn_s_sleep(1);
        if ((++sp & 255u) == 0u) { if (xb_ld(&bar[XB_TMO])) break; if (sp > XB_SPIN_CAP) { atomicAdd(&bar[XB_TMO], 1u); break; } }
    }
    nloc = mine > 0u ? mine : 1u; nx = cnt > 0u ? cnt : 1u;
}

__device__ __forceinline__ void xcd_barrier(const XcdBarrier& b) {
    asm volatile("s_waitcnt vmcnt(0)" ::: "memory");
    __syncthreads();
    if (threadIdx.x == 0) {
        unsigned* bar = b.bar;
        __builtin_amdgcn_s_waitcnt(0);
        unsigned nloc = b.st[0], nx = b.st[1];
        if (nloc == 0u) { xcd_barrier_complete(bar, b.x, nloc, nx); b.st[0] = nloc; b.st[1] = nx; }
        const unsigned old = xb_add(&bar[XB_XSUB(b.x)], 1u);
        const unsigned gen = old / nloc;
        if (old + 1u == (gen + 1u) * nloc) {
            __builtin_amdgcn_fence(__ATOMIC_RELEASE, "agent");
            asm volatile("s_waitcnt vmcnt(0)" ::: "memory");
            const unsigned og = xb_add(&bar[XB_TOP], 1u);
            const unsigned tg = og / nx;
            if (og + 1u == (tg + 1u) * nx) xb_add(&bar[XB_TOPGEN], 1u);
            else XB_SPIN(xb_ld(&bar[XB_TOPGEN]) == tg, bar);
            __builtin_amdgcn_fence(__ATOMIC_ACQUIRE, "agent");
            xb_add(&bar[XB_XGEN(b.x)], 1u);
            asm volatile("s_waitcnt vmcnt(0)" ::: "memory");
        } else {
            XB_SPIN(xb_ld(&bar[XB_XGEN(b.x)]) == gen, bar);
            __builtin_amdgcn_fence(__ATOMIC_ACQUIRE, "agent");
            asm volatile("s_waitcnt vmcnt(0)" ::: "memory");
        }
    }
    __syncthreads();
}


struct Args { const float* in[26]; float* out; unsigned char* ws; int ph_lo, ph_hi; };

__device__ __forceinline__ void p0_transpose_item(const float* W, int N, bf16* WT, int ldt, int row_off, int col_off, LAS float* scr, int item, int lane) {
    const int nblk = N / 32, kb = item / nblk, nb = item % nblk, k0 = 64 * kb, n0 = 32 * nb;
#pragma unroll 8
    for (int i = 0; i < 32; ++i) { const int kk = 2 * i + (lane >> 5); scr[kk * 33 + (lane & 31)] = W[(size_t)(k0 + kk) * N + n0 + (lane & 31)]; }
    LDS_WAIT(); asm volatile("" ::: "memory");
    const int c = lane & 7;
#pragma unroll
    for (int j = 0; j < 4; ++j) { const int n = (lane >> 3) + 8 * j; const LAS float* s = scr + (8 * c) * 33 + n;
        v4u o; o.x = pk2(s[0 * 33], s[1 * 33]); o.y = pk2(s[2 * 33], s[3 * 33]); o.z = pk2(s[4 * 33], s[5 * 33]); o.w = pk2(s[6 * 33], s[7 * 33]);
        *(GAS v4u*)(WT + (size_t)(row_off + n0 + n) * ldt + col_off + k0 + 8 * c) = o; }
    LDS_WAIT(); asm volatile("" ::: "memory");
}
__device__ __forceinline__ void rms_row_to_bf16(const float* xrow, const float* w, bf16* orow, int lane) {
    const GAS f32x4* xr = (const GAS f32x4*)xrow + lane; const GAS f32x4* wr = (const GAS f32x4*)w + lane;
    f32x4 v[8]; float s = 0.f;
#pragma unroll
    for (int j = 0; j < 8; ++j) { v[j] = xr[64 * j]; s += (v[j].x * v[j].x + v[j].y * v[j].y) + (v[j].z * v[j].z + v[j].w * v[j].w); }
    const float r = 1.0f / sqrtf(wave_sum(s) * (1.f / 2048.f) + 1e-6f);
    GAS v2u* o8 = (GAS v2u*)orow + lane;
#pragma unroll
    for (int j = 0; j < 8; ++j) { const f32x4 ww = wr[64 * j]; v2u o; o.x = pk2(v[j].x * r * ww.x, v[j].y * r * ww.y); o.y = pk2(v[j].z * r * ww.z, v[j].w * r * ww.w); o8[64 * j] = o; }
}
__device__ __forceinline__ void rms_row_to_bf16_i8(const float* xrow, const float* w, bf16* orow, unsigned char* qrow, float* qscale, int lane) {
    const GAS f32x4* xr = (const GAS f32x4*)xrow + lane; const GAS f32x4* wr = (const GAS f32x4*)w + lane;
    f32x4 v[8]; float s = 0.f;
#pragma unroll
    for (int j = 0; j < 8; ++j) { v[j] = xr[64 * j]; s += (v[j].x * v[j].x + v[j].y * v[j].y) + (v[j].z * v[j].z + v[j].w * v[j].w); }
    const float r = 1.0f / sqrtf(wave_sum(s) * (1.f / 2048.f) + 1e-6f);
    GAS v2u* o8 = (GAS v2u*)orow + lane; float am = 0.f;
#pragma unroll
    for (int j = 0; j < 8; ++j) { const f32x4 ww = wr[64 * j]; v[j] = v[j] * r * ww; v2u o; o.x = pk2(v[j].x, v[j].y); o.y = pk2(v[j].z, v[j].w); o8[64 * j] = o;
        am = fmaxf(am, fmaxf(fmaxf(fabsf(v[j].x), fabsf(v[j].y)), fmaxf(fabsf(v[j].z), fabsf(v[j].w)))); }
    am = fmaxf(wave_max(am), 1e-30f); const float inv = 127.0f / am;
#pragma unroll
    for (int j = 0; j < 8; ++j) { const unsigned q = ((unsigned)(int)rintf(v[j].x * inv) & 0xffu) | (((unsigned)(int)rintf(v[j].y * inv) & 0xffu) << 8) | (((unsigned)(int)rintf(v[j].z * inv) & 0xffu) << 16) | (((unsigned)(int)rintf(v[j].w * inv) & 0xffu) << 24);
        ((GAS unsigned*)qrow)[64 * j + lane] = q; }
    if (lane == 0) *qscale = am * (1.0f / 127.0f);
}
__device__ __forceinline__ void p0_win_absmax_item(const float* W, int N, unsigned* sbm, int item, int lane) {
    const int nblk = N / 32, kb = item / nblk, nb = item % nblk, k0 = 64 * kb, n0 = 32 * nb; float m = 0.f, wv[32];
#pragma unroll
    for (int i = 0; i < 32; ++i) wv[i] = W[(size_t)(k0 + 2 * i + (lane >> 5)) * N + n0 + (lane & 31)];
#pragma unroll
    for (int i = 0; i < 32; ++i) m = fmaxf(m, fabsf(wv[i]));
    m = fmaxf(m, __shfl_xor(m, 32));
    if (lane < 32) atomicMax(sbm + n0 + lane, __float_as_uint(m));
}
__device__ __forceinline__ void p0_win_i8_item(const float* W, int N, unsigned char* WT, int ldt, const unsigned* sbm, LAS float* scr, int item, int lane) {
    const int nblk = N / 32, kb = item / nblk, nb = item % nblk, k0 = 64 * kb, n0 = 32 * nb;
#pragma unroll 8
    for (int i = 0; i < 32; ++i) { const int kk = 2 * i + (lane >> 5); scr[kk * 33 + (lane & 31)] = W[(size_t)(k0 + kk) * N + n0 + (lane & 31)]; }
    LDS_WAIT(); asm volatile("" ::: "memory");
    const int c = lane & 7;
#pragma unroll
    for (int j = 0; j < 4; ++j) { const int n = (lane >> 3) + 8 * j; const LAS float* s = scr + (8 * c) * 33 + n; const float am = __uint_as_float(sbm[n0 + n]), inv = am > 0.f ? 127.0f / am : 0.f;
        unsigned q[2];
#pragma unroll
        for (int hh = 0; hh < 2; ++hh) q[hh] = ((unsigned)(int)rintf(s[(4 * hh) * 33] * inv) & 0xffu) | (((unsigned)(int)rintf(s[(4 * hh + 1) * 33] * inv) & 0xffu) << 8) | (((unsigned)(int)rintf(s[(4 * hh + 2) * 33] * inv) & 0xffu) << 16) | (((unsigned)(int)rintf(s[(4 * hh + 3) * 33] * inv) & 0xffu) << 24);
        v2u o; o.x = q[0]; o.y = q[1];
        *(GAS v2u*)(WT + (size_t)(n0 + n) * ldt + k0 + 8 * c) = o; }
    LDS_WAIT(); asm volatile("" ::: "memory");
}
__device__ __forceinline__ void rms_row_to_i8(const float* xrow, const float* w, unsigned char* qrow, float* qscale, int lane) {
    const GAS f32x4* xr = (const GAS f32x4*)xrow + lane; const GAS f32x4* wr = (const GAS f32x4*)w + lane;
    f32x4 v[8]; float s = 0.f;
#pragma unroll
    for (int j = 0; j < 8; ++j) { v[j] = __builtin_nontemporal_load(xr + 64 * j); s += (v[j].x * v[j].x + v[j].y * v[j].y) + (v[j].z * v[j].z + v[j].w * v[j].w); }
    const float r = 1.0f / sqrtf(wave_sum(s) * (1.f / 2048.f) + 1e-6f); float am = 0.f;
#pragma unroll
    for (int j = 0; j < 8; ++j) { const f32x4 ww = wr[64 * j]; v[j] = v[j] * r * ww; am = fmaxf(am, fmaxf(fmaxf(fabsf(v[j].x), fabsf(v[j].y)), fmaxf(fabsf(v[j].z), fabsf(v[j].w)))); }
    am = fmaxf(wave_max(am), 1e-30f); const float inv = 127.0f / am;
#pragma unroll
    for (int j = 0; j < 8; ++j) { const unsigned q = ((unsigned)(int)rintf(v[j].x * inv) & 0xffu) | (((unsigned)(int)rintf(v[j].y * inv) & 0xffu) << 8) | (((unsigned)(int)rintf(v[j].z * inv) & 0xffu) << 16) | (((unsigned)(int)rintf(v[j].w * inv) & 0xffu) << 24);
        ((GAS unsigned*)qrow)[64 * j + lane] = q; }
    if (lane == 0) *qscale = am * (1.0f / 127.0f);
}
__device__ __forceinline__ void p0_win_strip(const Args& A, LAS unsigned char* lds, int strip, int tid) {
    const int lane = tid & 63, wave = tid >> 6, n = lane & 31, half = lane >> 5; unsigned char* ws = A.ws;
    const float* W = A.in[2] + strip * 32 + n;
    LAS unsigned* T = (LAS unsigned*)lds; LAS float* cm = (LAS float*)(lds + LDSCTL_OFF + 4096);
    float m = 0.f;
#pragma unroll 1
    for (int i0 = 0; i0 < 64; i0 += 16) { float a[16], b[16];
#pragma unroll
        for (int i = 0; i < 16; ++i) { const int k = 256 * wave + 4 * (i0 + i) + 2 * half; a[i] = __builtin_nontemporal_load(W + (size_t)k * IN_COLS); b[i] = __builtin_nontemporal_load(W + (size_t)(k + 1) * IN_COLS); }
#pragma unroll
        for (int i = 0; i < 16; ++i) { const unsigned w2 = pk2(a[i], b[i]); m = fmaxf(m, fmaxf(fabsf(bflo(w2)), fabsf(bfhi(w2)))); const int k2 = 128 * wave + 2 * (i0 + i) + half; T[n * 1024 + ((k2 + n) & 1023)] = w2; } }
    m = fmaxf(m, __shfl_xor(m, 32)); if (half == 0) cm[wave * 32 + n] = m;
    __syncthreads();
    if (tid < 32) { float f = 0.f;
#pragma unroll
        for (int w = 0; w < 8; ++w) f = fmaxf(f, cm[w * 32 + tid]);
        cm[256 + tid] = f; ((unsigned*)(ws + WS_CTL + WS_SBM))[strip * 32 + tid] = __float_as_uint(f); }
    __syncthreads();
    unsigned char* WT = ws + WS_WIN + (size_t)strip * 32 * 2048;
#pragma unroll 4
    for (int j = 0; j < 16; ++j) { const int g = tid + NTHR * j, n2 = g >> 8, k8 = g & 255; const float am = cm[256 + n2], inv = am > 0.f ? 127.0f / am : 0.f; unsigned q[2];
#pragma unroll
        for (int hh = 0; hh < 2; ++hh) { const unsigned w0 = T[n2 * 1024 + ((4 * k8 + 2 * hh + n2) & 1023)], w1 = T[n2 * 1024 + ((4 * k8 + 2 * hh + 1 + n2) & 1023)];
            q[hh] = ((unsigned)(int)rintf(bflo(w0) * inv) & 0xffu) | (((unsigned)(int)rintf(bfhi(w0) * inv) & 0xffu) << 8) | (((unsigned)(int)rintf(bflo(w1) * inv) & 0xffu) << 16) | (((unsigned)(int)rintf(bfhi(w1) * inv) & 0xffu) << 24); }
        v2u o; o.x = q[0]; o.y = q[1]; *(GAS v2u*)(WT + (size_t)n2 * 2048 + k8 * 8) = o; }
    __syncthreads();
}
__device__ __forceinline__ void p0b_win(const Args& A, LAS unsigned char* lds, int vcu, int G, int tid) {
    const int lane = tid & 63, wave = tid >> 6; unsigned char* ws = A.ws; LAS float* scr = (LAS float*)(lds + wave * 16384);
    for (int it = vcu * NWAVES + wave; it < 32 * 360; it += G * NWAVES) p0_win_i8_item(A.in[2], IN_COLS, ws + WS_WIN, 2048, (const unsigned*)(ws + WS_CTL + WS_SBM), scr, it, lane);
}
__device__ __forceinline__ void p4_wq_copy(const Args& A, int bi, int nb, int tid) {
    bf16* WQH = (bf16*)(A.ws + WS_WQ); const float* wq = A.in[20]; const float* n2w = A.in[19];
    for (int i = bi * NTHR + tid; i < 2048 * 2048 / 4; i += nb * NTHR) { const int k = i >> 9, hc = (i & 511) * 4, hd = hc >> 8, c = hc & 255; const f32x4 t = *(const GAS f32x4*)(wq + (size_t)k * 2048 + hc) * n2w[k];
        v2u o; o.x = pk2(t.x, t.y); o.y = pk2(t.z, t.w); *(GAS v2u*)(WQH + ((size_t)hd * 2048 + k) * 256 + c) = o; }
}
__device__ __forceinline__ void p4_w_absmax(const Args& A, int bi, int nb, int tid) {
    const int lane = tid & 63, wave = tid >> 6; unsigned* sbrw = (unsigned*)(A.ws + WS_CTL + WS_SBRW);
    for (int it = bi * NWAVES + wave; it < 2 * 1024; it += nb * NWAVES) p0_win_absmax_item(A.in[16 + (it >> 10)], 2048, sbrw + 2048 * (it >> 10), it & 1023, lane);
}
__device__ __forceinline__ void p4_weight_transposes(const Args& A, LAS unsigned char* lds, int bi, int nb, int tid) {
    const int lane = tid & 63, wave = tid >> 6; unsigned char* ws = A.ws; LAS float* scr = (LAS float*)(lds + wave * 16384);
    constexpr int I_B = 16 * 64, I_O = 32 * 64;
    const unsigned* sbrw = (const unsigned*)(ws + WS_CTL + WS_SBRW);
    for (int it = bi * NWAVES + wave; it < 2 * I_B + I_O; it += nb * NWAVES) { int r = it;
        if (r < I_B) { p0_win_i8_item(A.in[16], 2048, ws + WS_WR, 1024, sbrw, scr, r, lane); continue; } r -= I_B;
        if (r < I_B) { p0_win_i8_item(A.in[17], 2048, ws + WS_WW, 1024, sbrw + 2048, scr, r, lane); continue; } r -= I_B;
        p0_transpose_item(A.in[18], 2048, (bf16*)(ws + WS_WO), 2048, 0, 0, scr, r, lane); }
}
__device__ __forceinline__ void p0_prologue(const Args& A, LAS unsigned char* lds, int vcu, int G, int tid) {
    const int lane = tid & 63, wave = tid >> 6;
    unsigned char* ws = A.ws;
    LAS float* scr = (LAS float*)(lds + wave * 16384);
    const int gw = vcu * NWAVES + wave, NGW = G * NWAVES;
    constexpr int I_IN = 32 * 360, I_B = 16 * 64, I_O = 32 * 64, I_L = 32;
    constexpr int NITEMS = I_IN + 2 * I_B + 2 * I_O + 4 * I_L;
    for (int it = gw; it < NITEMS; it += NGW) {
        int r = it;
        if (r < I_IN) { continue; } r -= I_IN;
        if (r < 2 * I_B + I_O) { continue; } r -= 2 * I_B + I_O;
        if (r < I_O) { continue; } r -= I_O;
        if (r < I_L) { p0_transpose_item(A.in[7], 1024, (bf16*)(ws + WS_WLORA), 256, 0, 0, scr, r, lane); continue; } r -= I_L;
        if (r < I_L) { p0_transpose_item(A.in[9], 1024, (bf16*)(ws + WS_WLORA), 256, 1024, 64, scr, r, lane); continue; } r -= I_L;
        p0_transpose_item(A.in[10], 1024, (bf16*)(ws + WS_WLORA), 256, 2048, 128, scr, r, lane);
    }
    const int gt = vcu * NTHR + tid, NGT = G * NTHR;
    { bf16* WL = (bf16*)(ws + WS_WLORA);
      for (int i = gt; i < 3072 * 256; i += NGT) { const int r = i >> 8, c = i & 255; const bool nz = (r < 1024) ? (c < 64) : (r < 2048) ? (c >= 64 && c < 128) : (c >= 128); if (!nz) WL[i] = 0; } }
    { bf16* KB = (bf16*)(ws + WS_KEYS); const float* k1 = A.in[21]; const float* k2 = A.in[22];
      for (int i = gt; i < 256 * 256; i += NGT) { const int r = i >> 8, c = i & 255; float v = 0.f; if (r < 128 && c < 128) v = k1[r * 128 + c]; else if (r >= 128 && c >= 128) v = k2[(r - 128) * 128 + (c - 128)]; KB[i] = (bf16)f2bf(v); } }
    { float* rc = (float*)(ws + WS_ROT); float* rs = rc + 4096 * 128;
      for (int i = gt; i < 4096 * 128; i += NGT) { const int pos = i >> 7, j = i & 127; const float inv = exp2f(-(float)j * 0.10381025296523008f);
          double rev = (double)((float)pos * inv) * 0.15915494309189535; rev -= floor(rev); const float fr = (float)rev;
          rc[i] = __builtin_amdgcn_cosf(fr); rs[i] = __builtin_amdgcn_sinf(fr); } }
    {
        const GAS f32x4* wr = (const GAS f32x4*)A.in[1] + lane; f32x4 nv[8];
        if (gw < NTOK) { const GAS f32x4* xr = (const GAS f32x4*)(A.in[0] + (size_t)gw * DM) + lane;
#pragma unroll
            for (int j = 0; j < 8; ++j) nv[j] = __builtin_nontemporal_load(xr + 64 * j); }
#pragma unroll 1
        for (int m = gw; m < NTOK; m += NGW) { f32x4 v[8]; float sq = 0.f;
#pragma unroll
            for (int j = 0; j < 8; ++j) v[j] = nv[j];
            if (m + NGW < NTOK) { const GAS f32x4* xr = (const GAS f32x4*)(A.in[0] + (size_t)(m + NGW) * DM) + lane;
#pragma unroll
                for (int j = 0; j < 8; ++j) nv[j] = __builtin_nontemporal_load(xr + 64 * j); }
#pragma unroll
            for (int j = 0; j < 8; ++j) sq += (v[j].x * v[j].x + v[j].y * v[j].y) + (v[j].z * v[j].z + v[j].w * v[j].w);
            const float r = 1.0f / sqrtf(wave_sum(sq) * (1.f / 2048.f) + 1e-6f); float am = 0.f;
#pragma unroll
            for (int j = 0; j < 8; ++j) { const f32x4 ww = wr[64 * j]; v[j] = v[j] * r * ww; am = fmaxf(am, fmaxf(fmaxf(fabsf(v[j].x), fabsf(v[j].y)), fmaxf(fabsf(v[j].z), fabsf(v[j].w)))); }
            am = fmaxf(wave_max(am), 1e-30f); const float inv = 127.0f / am; unsigned char* qrow = ws + WS_H + (size_t)m * DM;
#pragma unroll
            for (int j = 0; j < 8; ++j) { const unsigned q = ((unsigned)(int)rintf(v[j].x * inv) & 0xffu) | (((unsigned)(int)rintf(v[j].y * inv) & 0xffu) << 8) | (((unsigned)(int)rintf(v[j].z * inv) & 0xffu) << 16) | (((unsigned)(int)rintf(v[j].w * inv) & 0xffu) << 24);
                ((GAS unsigned*)qrow)[64 * j + lane] = q; }
            if (lane == 0) ((float*)(ws + WS_SA))[m] = am * (1.0f / 127.0f); } }
}

__device__ __forceinline__ void p2a_lerp(const Args& A, int vcu, int G, int tid) {
    const int lane = tid & 63, wave = tid >> 6; unsigned char* ws = A.ws;
    const bf16* Zr = (const bf16*)(ws + WS_ZR); bf16* RKV = (bf16*)(ws + WS_RKV); bf16* L = (bf16*)(ws + WS_L); const float* mix = A.in[5];
    const int gw = vcu * NWAVES + wave, NGW = G * NWAVES;
    for (int n = gw; n < NTOK; n += NGW) { const int t = n & (SEQ - 1);
        for (int v = lane; v < ZRC / 8; v += 64) { const int c0 = 8 * v;
            const v4u zz = *(const GAS v4u*)(Zr + (size_t)n * ZRC + c0); v4u zp = {0u, 0u, 0u, 0u}; if (t > 0) zp = *(const GAS v4u*)(Zr + (size_t)(n - 1) * ZRC + c0);
            const f32x4 m0 = *(const GAS f32x4*)(mix + c0), m1 = *(const GAS f32x4*)(mix + c0 + 4);
            float z[8], p[8], mx[8] = {m0.x, m0.y, m0.z, m0.w, m1.x, m1.y, m1.z, m1.w};
            z[0] = bflo(zz.x); z[1] = bfhi(zz.x); z[2] = bflo(zz.y); z[3] = bfhi(zz.y); z[4] = bflo(zz.z); z[5] = bfhi(zz.z); z[6] = bflo(zz.w); z[7] = bfhi(zz.w);
            p[0] = bflo(zp.x); p[1] = bfhi(zp.x); p[2] = bflo(zp.y); p[3] = bfhi(zp.y); p[4] = bflo(zp.z); p[5] = bfhi(zp.z); p[6] = bflo(zp.w); p[7] = bfhi(zp.w);
#pragma unroll
            for (int j = 0; j < 8; ++j) z[j] = z[j] + (p[j] - z[j]) * mx[j];
            bf16* dst;
            if (c0 < 3072) dst = RKV + (size_t)n * 3072 + c0;
            else if (c0 < 3136) { dst = L + (size_t)n * 256 + (c0 - 3072);
#pragma unroll
                for (int j = 0; j < 8; ++j) z[j] = 1.0f - 2.0f / (1.0f + __expf(2.0f * z[j])); }
            else if (c0 < 3200) dst = L + (size_t)n * 256 + 64 + (c0 - 3136);
            else { dst = L + (size_t)n * 256 + 128 + (c0 - 3200);
#pragma unroll
                for (int j = 0; j < 8; ++j) z[j] = sigm(z[j]); }
            v4u o; o.x = pk2(z[0], z[1]); o.y = pk2(z[2], z[3]); o.z = pk2(z[4], z[5]); o.w = pk2(z[6], z[7]);
            *(GAS v4u*)dst = o; } }
}
__device__ __forceinline__ float ret_log2g(int h) { return log2f(1.0f - exp2f(-5.0f - (float)h)); }
__device__ __forceinline__ void p2a_ret_transpose(const Args& A, LAS unsigned char* lds, int vcu, int G, int tid) {
    const int lane = tid & 63, wave = tid >> 6; unsigned char* ws = A.ws;
    LAS bf16* scr = (LAS bf16*)(lds + wave * 16384);
    const int gw = vcu * NWAVES + wave, NGW = G * NWAVES;
    for (int it = gw; it < 2 * 8 * 64 * 4; it += NGW) {
        const int which = it >> 11, bh = (it >> 8) & 7, c = (it >> 2) & 63, db = it & 3, b = bh >> 2, h = bh & 3;
        const bf16* src = (const bf16*)(ws + (which ? WS_VR : WS_KB)) + (size_t)(b * SEQ + c * 64) * 1024 + h * 256 + db * 64;
#pragma unroll 8
        for (int m = 0; m < 64; ++m) scr[m * 66 + lane] = src[(size_t)m * 1024 + lane];
        LDS_WAIT(); asm volatile("" ::: "memory");
        bf16* d0 = (bf16*)(ws + (which ? WS_VT : WS_KT)) + (size_t)(bh * 64 + c) * 256 * 64;
        bf16* d1 = (bf16*)(ws + WS_VDT) + (size_t)(bh * 64 + c) * 256 * 64;
        const int ch = lane & 7, m0 = 8 * ch; const float l2g = ret_log2g(h);
#pragma unroll
        for (int j = 0; j < 8; ++j) { const int d = (lane >> 3) + 8 * j; float f[8];
            const size_t fo = (size_t)(((((db * 4 + (d >> 4)) * 2 + (ch >> 2)) * 4 + (ch & 3)) * 16 + (d & 15)) * 8);
#pragma unroll
            for (int i = 0; i < 8; ++i) f[i] = bf1(scr[(m0 + i) * 66 + d]);
            v4u o; o.x = pk2(f[0], f[1]); o.y = pk2(f[2], f[3]); o.z = pk2(f[4], f[5]); o.w = pk2(f[6], f[7]);
            *(GAS v4u*)(d0 + fo) = o;
            if (which) {
#pragma unroll
                for (int i = 0; i < 8; ++i) f[i] *= exp2f(l2g * (float)(63 - (m0 + i)));
                o.x = pk2(f[0], f[1]); o.y = pk2(f[2], f[3]); o.z = pk2(f[4], f[5]); o.w = pk2(f[6], f[7]);
                *(GAS v4u*)(d1 + fo) = o; } }
        LDS_WAIT(); asm volatile("" ::: "memory");
    }
}

__device__ __forceinline__ void group_barrier(unsigned* cnt, unsigned target, int tid) {
    asm volatile("s_waitcnt vmcnt(0)" ::: "memory"); __syncthreads();
    if (tid == 0) {
        __builtin_amdgcn_fence(__ATOMIC_RELEASE, "agent"); asm volatile("s_waitcnt vmcnt(0)" ::: "memory");
        __hip_atomic_fetch_add(cnt, 1u, __ATOMIC_RELAXED, __HIP_MEMORY_SCOPE_AGENT);
        unsigned sp = 0; while (__hip_atomic_load(cnt, __ATOMIC_RELAXED, __HIP_MEMORY_SCOPE_AGENT) < target) { __builtin_amdgcn_s_sleep(2); if (++sp > (1u << 22)) break; }
        __builtin_amdgcn_fence(__ATOMIC_ACQUIRE, "agent"); asm volatile("s_waitcnt vmcnt(0)" ::: "memory");
    }
    __syncthreads();
}
struct RetA { const bf16 *Qc, *Kc, *Ktc, *Vtc, *Vdtc; bf16 *KV, *Oret; LAS bf16* Pl; size_t tok0; float l2g; int h; };
__device__ __forceinline__ RetA ret_a_setup(const Args& A, LAS unsigned char* lds, int bh, int c, int slot) {
    unsigned char* ws = A.ws; RetA U; const int b = bh >> 2, h = bh & 3; U.h = h; U.l2g = ret_log2g(h); U.tok0 = (size_t)b * SEQ + c * 64;
    U.Pl = (LAS bf16*)(lds + slot * 9216);
    U.Qc = (const bf16*)(ws + WS_QB) + U.tok0 * 1024 + h * 256; U.Kc = (const bf16*)(ws + WS_KB) + U.tok0 * 1024 + h * 256;
    U.Ktc = (const bf16*)(ws + WS_KT) + (size_t)(bh * 64 + c) * 256 * 64; U.Vtc = (const bf16*)(ws + WS_VT) + (size_t)(bh * 64 + c) * 256 * 64; U.Vdtc = (const bf16*)(ws + WS_VDT) + (size_t)(bh * 64 + c) * 256 * 64;
    U.Oret = (bf16*)(ws + WS_ORET); U.KV = (bf16*)A.out + (size_t)(bh * 64 + c) * 65536;
    return U; }
__device__ __forceinline__ void ret_a_scores(const RetA& U, int tid) {
    const int lane = tid & 63, w = tid >> 6, fr = lane & 15, fq = lane >> 4, nb = w >> 1, mb0 = 2 * (w & 1);
    f32x4 accP[2] = {(f32x4){0.f, 0.f, 0.f, 0.f}, (f32x4){0.f, 0.f, 0.f, 0.f}};
#pragma unroll
    for (int ks = 0; ks < 8; ++ks) { const bf16x8 aq = *(const GAS bf16x8*)(U.Qc + (size_t)(nb * 16 + fr) * 1024 + ks * 32 + fq * 8);
#pragma unroll
        for (int t = 0; t < 2; ++t) { const bf16x8 bk = *(const GAS bf16x8*)(U.Kc + (size_t)((mb0 + t) * 16 + fr) * 1024 + ks * 32 + fq * 8); accP[t] = mfma16(aq, bk, accP[t]); } }
#pragma unroll
    for (int t = 0; t < 2; ++t)
#pragma unroll
        for (int r = 0; r < 4; ++r) { const int n = nb * 16 + 4 * fq + r, m = (mb0 + t) * 16 + fr; const int dd = n > m ? n - m : m - n;
            U.Pl[n * 72 + m] = (bf16)f2bf(accP[t][r] * exp2f(U.l2g * (float)dd)); }
}
__device__ __forceinline__ void ret_a_rest(const RetA& U, int tid) {
    const int lane = tid & 63, w = tid >> 6, fr = lane & 15, fq = lane >> 4, nb = w >> 1;
    {
        bf16x8 pf[2];
#pragma unroll
        for (int ks = 0; ks < 2; ++ks) pf[ks] = *(const LAS bf16x8*)(U.Pl + (nb * 16 + fr) * 72 + ks * 32 + fq * 8);
#pragma unroll
        for (int e8 = 0; e8 < 8; ++e8) { const int eb = (w & 1) * 8 + e8; f32x4 acc = {0.f, 0.f, 0.f, 0.f};
#pragma unroll
            for (int ks = 0; ks < 2; ++ks) { const bf16x8 vf = *(const GAS bf16x8*)(U.Vtc + (size_t)((((eb * 2 + ks) * 4 + fq) * 16 + fr) * 8)); acc = mfma16(vf, pf[ks], acc); }
            v2u o; o.x = pk2(acc[0], acc[1]); o.y = pk2(acc[2], acc[3]);
            *(GAS v2u*)(U.Oret + (U.tok0 + nb * 16 + fr) * 1024 + U.h * 256 + eb * 16 + 4 * fq) = o; }
    }
    {
        bf16x8 kf[2][2];
#pragma unroll
        for (int t = 0; t < 2; ++t)
#pragma unroll
            for (int ks = 0; ks < 2; ++ks) kf[t][ks] = *(const GAS bf16x8*)(U.Ktc + (size_t)(((((2 * w + t) * 2 + ks) * 4 + fq) * 16 + fr) * 8));
#pragma unroll
        for (int eb = 0; eb < 16; ++eb) { bf16x8 vf[2];
#pragma unroll
            for (int ks = 0; ks < 2; ++ks) vf[ks] = *(const GAS bf16x8*)(U.Vdtc + (size_t)((((eb * 2 + ks) * 4 + fq) * 16 + fr) * 8));
#pragma unroll
            for (int t = 0; t < 2; ++t) { f32x4 acc = {0.f, 0.f, 0.f, 0.f};
#pragma unroll
                for (int ks = 0; ks < 2; ++ks) acc = mfma16(kf[t][ks], vf[ks], acc);
                v2u o; o.x = pk2(acc[0], acc[1]); o.y = pk2(acc[2], acc[3]);
                *(GAS v2u*)(U.KV + (size_t)(((((eb * 8 + w) * 4 + 2 * t + (fq >> 1)) * 16 + fr) * 8) + 4 * (fq & 1))) = o; } }
    }
}
typedef unsigned short u16x4_t __attribute__((ext_vector_type(4)));
constexpr int RT_PITCH = 528, RT_TILE = 64 * RT_PITCH;
__device__ __forceinline__ void tr_frag2(unsigned tile, int c, int lane, bf16x8& f0, bf16x8& f1) {
    const unsigned g = lane >> 4, q = (lane & 15) >> 2, pp = lane & 3;
    const unsigned a0 = tile + (8 * g + q) * RT_PITCH + 32 * c + 8 * pp;
    u16x4_t r0, r1, r2, r3;
    asm volatile("ds_read_b64_tr_b16 %0, %4\n\tds_read_b64_tr_b16 %1, %4 offset:2112\n\tds_read_b64_tr_b16 %2, %4 offset:16896\n\tds_read_b64_tr_b16 %3, %4 offset:19008\n\ts_waitcnt lgkmcnt(0)"
                 : "=&v"(r0), "=&v"(r1), "=&v"(r2), "=&v"(r3) : "v"(a0) : "memory");
    f0 = __builtin_bit_cast(bf16x8, __builtin_shufflevector(r0, r1, 0, 1, 2, 3, 4, 5, 6, 7)); f1 = __builtin_bit_cast(bf16x8, __builtin_shufflevector(r2, r3, 0, 1, 2, 3, 4, 5, 6, 7));
}
__device__ __forceinline__ void tr_frag2x4(unsigned tile, int c, int lane, bf16x8 (&f)[4][2]) {
    const unsigned g = lane >> 4, q = (lane & 15) >> 2, pp = lane & 3;
    const unsigned a0 = tile + (8 * g + q) * RT_PITCH + 32 * c + 8 * pp;
    u16x4_t r[16];
    asm volatile("ds_read_b64_tr_b16 %0, %16\n\tds_read_b64_tr_b16 %1, %16 offset:2112\n\tds_read_b64_tr_b16 %2, %16 offset:16896\n\tds_read_b64_tr_b16 %3, %16 offset:19008\n\t"
                 "ds_read_b64_tr_b16 %4, %16 offset:32\n\tds_read_b64_tr_b16 %5, %16 offset:2144\n\tds_read_b64_tr_b16 %6, %16 offset:16928\n\tds_read_b64_tr_b16 %7, %16 offset:19040\n\t"
                 "ds_read_b64_tr_b16 %8, %16 offset:64\n\tds_read_b64_tr_b16 %9, %16 offset:2176\n\tds_read_b64_tr_b16 %10, %16 offset:16960\n\tds_read_b64_tr_b16 %11, %16 offset:19072\n\t"
                 "ds_read_b64_tr_b16 %12, %16 offset:96\n\tds_read_b64_tr_b16 %13, %16 offset:2208\n\tds_read_b64_tr_b16 %14, %16 offset:16992\n\tds_read_b64_tr_b16 %15, %16 offset:19104\n\ts_waitcnt lgkmcnt(0)"
                 : "=&v"(r[0]), "=&v"(r[1]), "=&v"(r[2]), "=&v"(r[3]), "=&v"(r[4]), "=&v"(r[5]), "=&v"(r[6]), "=&v"(r[7]), "=&v"(r[8]), "=&v"(r[9]), "=&v"(r[10]), "=&v"(r[11]), "=&v"(r[12]), "=&v"(r[13]), "=&v"(r[14]), "=&v"(r[15])
                 : "v"(a0) : "memory");
#pragma unroll
    for (int j = 0; j < 4; ++j) { f[j][0] = __builtin_bit_cast(bf16x8, __builtin_shufflevector(r[4 * j], r[4 * j + 1], 0, 1, 2, 3, 4, 5, 6, 7)); f[j][1] = __builtin_bit_cast(bf16x8, __builtin_shufflevector(r[4 * j + 2], r[4 * j + 3], 0, 1, 2, 3, 4, 5, 6, 7)); }
}
__device__ __forceinline__ void ret_units_a3(const Args& A, LAS unsigned char* lds, int u0, int un, int tid) {
    unsigned char* ws = A.ws;
    const int lane = tid & 63, w = tid >> 6, fr = lane & 15, fq = lane >> 4, nb = w >> 1, mb0 = 2 * (w & 1);
    const int bh = u0 >> 6, b = bh >> 2, h = bh & 3; const float l2g = ret_log2g(h);
    LAS unsigned char* TK = lds; LAS unsigned char* TV = lds + RT_TILE; LAS unsigned char* TD = lds + 2 * RT_TILE; LAS bf16* Pl = (LAS bf16*)(lds + 3 * RT_TILE);
    const unsigned tk = (unsigned)(size_t)TK, tv = (unsigned)(size_t)TV, td = (unsigned)(size_t)TD;
    const int row = tid >> 3, ch0 = (tid & 7) * 4; const float kd = exp2f(l2g * (float)(63 - row));
    bf16* Oret = (bf16*)(ws + WS_ORET);
    v4u kq[4], vq[4]; bf16x8 aq[8];
    auto request = [&](int u) { const size_t tok0 = (size_t)b * SEQ + (u & 63) * 64;
        const bf16* Qc = (const bf16*)(ws + WS_QB) + tok0 * 1024 + h * 256; const bf16* Kc = (const bf16*)(ws + WS_KB) + tok0 * 1024 + h * 256; const bf16* Vc = (const bf16*)(ws + WS_VR) + tok0 * 1024 + h * 256;
#pragma unroll
        for (int i = 0; i < 4; ++i) { kq[i] = *(const GAS v4u*)(Kc + (size_t)row * 1024 + (ch0 + i) * 8); vq[i] = *(const GAS v4u*)(Vc + (size_t)row * 1024 + (ch0 + i) * 8); }
#pragma unroll
        for (int ks = 0; ks < 8; ++ks) aq[ks] = *(const GAS bf16x8*)(Qc + (size_t)(nb * 16 + fr) * 1024 + ks * 32 + fq * 8); };
    request(u0);
#pragma unroll 1
    for (int u = u0; u < u0 + un; ++u) { const int c = u & 63; const size_t tok0 = (size_t)b * SEQ + c * 64; bf16* KV = (bf16*)A.out + (size_t)(bh * 64 + c) * 65536;
#pragma unroll
        for (int i = 0; i < 4; ++i) { const int ch = ch0 + i; *(LAS v4u*)(TK + row * RT_PITCH + ch * 16) = kq[i]; *(LAS v4u*)(TV + row * RT_PITCH + ch * 16) = vq[i];
            v4u dq; dq.x = pk2(bflo(vq[i].x) * kd, bfhi(vq[i].x) * kd); dq.y = pk2(bflo(vq[i].y) * kd, bfhi(vq[i].y) * kd); dq.z = pk2(bflo(vq[i].z) * kd, bfhi(vq[i].z) * kd); dq.w = pk2(bflo(vq[i].w) * kd, bfhi(vq[i].w) * kd);
            *(LAS v4u*)(TD + row * RT_PITCH + ch * 16) = dq; }
        bf16x8 q8[8];
#pragma unroll
        for (int ks = 0; ks < 8; ++ks) q8[ks] = aq[ks];
        __syncthreads();
        if (u + 1 < u0 + un) request(u + 1);
        {
            f32x4 accP[2] = {(f32x4){0.f, 0.f, 0.f, 0.f}, (f32x4){0.f, 0.f, 0.f, 0.f}};
#pragma unroll
            for (int ks = 0; ks < 8; ++ks)
#pragma unroll
                for (int t = 0; t < 2; ++t) { const bf16x8 bk = *(const LAS bf16x8*)(TK + ((mb0 + t) * 16 + fr) * RT_PITCH + (ks * 32 + fq * 8) * 2); accP[t] = mfma16(q8[ks], bk, accP[t]); }
#pragma unroll
            for (int t = 0; t < 2; ++t)
#pragma unroll
                for (int r = 0; r < 4; ++r) { const int n = nb * 16 + 4 * fq + r, m = (mb0 + t) * 16 + fr; const int dd = n > m ? n - m : m - n;
                    Pl[n * 72 + m] = (bf16)f2bf(accP[t][r] * exp2f(l2g * (float)dd)); }
        }
        __syncthreads();
        {
            bf16x8 pf[2];
#pragma unroll
            for (int ks = 0; ks < 2; ++ks) pf[ks] = *(const LAS bf16x8*)(Pl + (nb * 16 + fr) * 72 + ks * 32 + fq * 8);
#pragma unroll
            for (int e4 = 0; e4 < 2; ++e4) { bf16x8 vv[4][2]; tr_frag2x4(tv, (w & 1) * 8 + e4 * 4, lane, vv);
#pragma unroll
                for (int j = 0; j < 4; ++j) { const int eb = (w & 1) * 8 + e4 * 4 + j; f32x4 acc = {0.f, 0.f, 0.f, 0.f}; acc = mfma16(vv[j][0], pf[0], acc); acc = mfma16(vv[j][1], pf[1], acc);
                    v2u o; o.x = pk2(acc[0], acc[1]); o.y = pk2(acc[2], acc[3]);
                    *(GAS v2u*)(Oret + (tok0 + nb * 16 + fr) * 1024 + h * 256 + eb * 16 + 4 * fq) = o; } }
        }
        {
            bf16x8 kf[2][2];
#pragma unroll
            for (int t = 0; t < 2; ++t) tr_frag2(tk, 2 * w + t, lane, kf[t][0], kf[t][1]);
#pragma unroll
            for (int e4 = 0; e4 < 4; ++e4) { bf16x8 vv[4][2]; tr_frag2x4(td, e4 * 4, lane, vv);
#pragma unroll
                for (int j = 0; j < 4; ++j) { const int eb = e4 * 4 + j;
#pragma unroll
                    for (int t = 0; t < 2; ++t) { f32x4 acc = {0.f, 0.f, 0.f, 0.f};
#pragma unroll
                        for (int ks = 0; ks < 2; ++ks) acc = mfma16(kf[t][ks], vv[j][ks], acc);
                        v2u o; o.x = pk2(acc[0], acc[1]); o.y = pk2(acc[2], acc[3]);
                        *(GAS v2u*)(KV + (size_t)(((((eb * 8 + w) * 4 + 2 * t + (fq >> 1)) * 16 + fr) * 8) + 4 * (fq & 1))) = o; } } }
        }
        __syncthreads();
    }
}
__device__ __forceinline__ void ret_unit_a2(const Args& A, LAS unsigned char* lds, int bh, int c, int tid) {
    const RetA U0 = ret_a_setup(A, lds, bh, c, 0), U1 = ret_a_setup(A, lds, bh, c + 1, 1);
    ret_a_scores(U0, tid); ret_a_scores(U1, tid);
    __syncthreads();
    ret_a_rest(U0, tid); ret_a_rest(U1, tid);
    __syncthreads();
}
__device__ __forceinline__ void ret_scan_b(const Args& A, int gi, int ng, int tid) {
    bf16* KV = (bf16*)A.out;
    for (int it = gi * NTHR + tid; it < 8 * 8192; it += ng * NTHR) { const int bh = it >> 13, vec = it & 8191; const float cd = exp2f(ret_log2g(bh & 3) * 64.0f);
        bf16* p = KV + (size_t)bh * 64 * 65536 + vec * 8; float sx[8];
#pragma unroll
        for (int i = 0; i < 8; ++i) sx[i] = 0.f;
#pragma unroll 1
        for (int c0 = 0; c0 < 64; c0 += 32) { v4u kv[32];
#pragma unroll
            for (int j = 0; j < 32; ++j) kv[j] = *(const GAS v4u*)(p + (size_t)(c0 + j) * 65536);
#pragma unroll
            for (int j = 0; j < 32; ++j) { v4u o; o.x = pk2(sx[0], sx[1]); o.y = pk2(sx[2], sx[3]); o.z = pk2(sx[4], sx[5]); o.w = pk2(sx[6], sx[7]);
                *(GAS v4u*)(p + (size_t)(c0 + j) * 65536) = o;
                sx[0] = sx[0] * cd + bflo(kv[j].x); sx[1] = sx[1] * cd + bfhi(kv[j].x); sx[2] = sx[2] * cd + bflo(kv[j].y); sx[3] = sx[3] * cd + bfhi(kv[j].y);
                sx[4] = sx[4] * cd + bflo(kv[j].z); sx[5] = sx[5] * cd + bfhi(kv[j].z); sx[6] = sx[6] * cd + bflo(kv[j].w); sx[7] = sx[7] * cd + bfhi(kv[j].w); } } }
}
__device__ __forceinline__ void ret_unit_c(const Args& A, int bh, int c, int tid) {
    unsigned char* ws = A.ws;
    const int lane = tid & 63, w = tid >> 6, fr = lane & 15, fq = lane >> 4, b = bh >> 2, h = bh & 3;
    const float l2g = ret_log2g(h);
    const size_t tok0 = (size_t)b * SEQ + c * 64;
    const bf16* Qc = (const bf16*)(ws + WS_QB) + tok0 * 1024 + h * 256;
    const bf16* Sc = (const bf16*)A.out + (size_t)(bh * 64 + c) * 65536;
    bf16* Oret = (bf16*)(ws + WS_ORET);
    f32x4 acc[2][4];
#pragma unroll
    for (int t = 0; t < 2; ++t)
#pragma unroll
        for (int nb = 0; nb < 4; ++nb) acc[t][nb] = (f32x4){0.f, 0.f, 0.f, 0.f};
#pragma unroll
    for (int ks = 0; ks < 8; ++ks) { bf16x8 sf[2], qf[4];
#pragma unroll
        for (int t = 0; t < 2; ++t) sf[t] = *(const GAS bf16x8*)(Sc + (size_t)(((((2 * w + t) * 8 + ks) * 4 + fq) * 16 + fr) * 8));
#pragma unroll
        for (int nb = 0; nb < 4; ++nb) qf[nb] = *(const GAS bf16x8*)(Qc + (size_t)(nb * 16 + fr) * 1024 + ks * 32 + fq * 8);
#pragma unroll
        for (int t = 0; t < 2; ++t)
#pragma unroll
            for (int nb = 0; nb < 4; ++nb) acc[t][nb] = mfma16(sf[t], qf[nb], acc[t][nb]); }
#pragma unroll
    for (int nb = 0; nb < 4; ++nb) { const float qd = exp2f(l2g * (float)(nb * 16 + fr + 1));
#pragma unroll
        for (int t = 0; t < 2; ++t) { bf16* op = Oret + (tok0 + nb * 16 + fr) * 1024 + h * 256 + (2 * w + t) * 16 + 4 * fq;
            const v2u o0 = *(const GAS v2u*)op; v2u o;
            o.x = pk2(bflo(o0.x) + qd * acc[t][nb][0], bfhi(o0.x) + qd * acc[t][nb][1]); o.y = pk2(bflo(o0.y) + qd * acc[t][nb][2], bfhi(o0.y) + qd * acc[t][nb][3]);
            *(GAS v2u*)op = o; } }
}

constexpr int RTS = 32;
__device__ __forceinline__ void rwkv_scan_unit(const Args& A, LAS unsigned char* lds, int bh, int rq, int cvt_unit, int cvt_n, int tid) {
    unsigned char* ws = A.ws;
    const int b = bh >> 4, h = bh & 15, lane = tid & 63;
    const bf16* RKV = (const bf16*)(ws + WS_RKV); const bf16* Ab = (const bf16*)(ws + WS_AB); const float* DEC = (const float*)(ws + WS_DEC); bf16* Y = (bf16*)(ws + WS_Y);
    const int lt = tid & 255, ts = lt >> 4, jq = lt & 15, j0 = 4 * jq;
    const int irow = rq * 16 + ((tid >> 4) & 15), jj = tid & 15;
    const bool scanner = tid < 256;
    const f32x4 kkw = *(const GAS f32x4*)(A.in[11] + h * 64 + j0), kaw = *(const GAS f32x4*)(A.in[12] + h * 64 + j0);
    auto sbuf = [&](int b2, int arr) -> LAS float* { return (LAS float*)(lds + b2 * 49152 + arr * 8192); };
    v2u lr[2], lk[2], lv[2], la[2]; f32x4 lw[2];
    auto issue = [&](int st) {
#pragma unroll
        for (int u = 0; u < 2; ++u) { const size_t n = (size_t)b * SEQ + st * RTS + ts + 16 * u;
            lr[u] = *(const GAS v2u*)(RKV + n * 3072 + h * 64 + j0); lk[u] = *(const GAS v2u*)(RKV + n * 3072 + 1024 + h * 64 + j0); lv[u] = *(const GAS v2u*)(RKV + n * 3072 + 2048 + h * 64 + j0);
            la[u] = *(const GAS v2u*)(Ab + n * 1024 + h * 64 + j0); lw[u] = *(const GAS f32x4*)(DEC + n * 1024 + h * 64 + j0); } };
    auto commit = [&](int b2) {
#pragma unroll
        for (int u = 0; u < 2; ++u) { const int t2 = ts + 16 * u;
            const f32x4 k = {bflo(lk[u].x), bfhi(lk[u].x), bflo(lk[u].y), bfhi(lk[u].y)}, a = {bflo(la[u].x), bfhi(la[u].x), bflo(la[u].y), bfhi(la[u].y)};
            const f32x4 r = {bflo(lr[u].x), bfhi(lr[u].x), bflo(lr[u].y), bfhi(lr[u].y)}, v = {bflo(lv[u].x), bfhi(lv[u].x), bflo(lv[u].y), bfhi(lv[u].y)};
            f32x4 kk = k * kkw; float ss = (kk.x * kk.x + kk.y * kk.y) + (kk.z * kk.z + kk.w * kk.w); ss = rowsum16(ss);
            const float inv = 1.0f / fmaxf(sqrtf(ss), 1e-12f); kk = kk * inv;
            const f32x4 kka = kk * a, kp = k * (1.0f + (a - 1.0f) * kaw);
            *(LAS f32x4*)(sbuf(b2, 0) + t2 * 64 + j0) = kk; *(LAS f32x4*)(sbuf(b2, 1) + t2 * 64 + j0) = kka; *(LAS f32x4*)(sbuf(b2, 2) + t2 * 64 + j0) = lw[u];
            *(LAS f32x4*)(sbuf(b2, 3) + t2 * 64 + j0) = kp; *(LAS f32x4*)(sbuf(b2, 4) + t2 * 64 + j0) = r; *(LAS f32x4*)(sbuf(b2, 5) + t2 * 64 + j0) = v; } };
    const int cw = cvt_unit * 4 + ((tid >> 6) & 3), cstride = 4 * cvt_n; int crow = cw; float cx[32];
    auto cvt_load = [&]() { if (crow < 2 * 16384) { const float* src = A.in[23 + (crow >> 14)] + (size_t)(crow & 16383) * DM;
#pragma unroll
            for (int j = 0; j < 2; ++j)
#pragma unroll
                for (int q = 0; q < 4; ++q) { const f32x4 t = *(const GAS f32x4*)(src + j * 1024 + lane * 16 + q * 4); cx[j * 16 + q * 4] = t.x; cx[j * 16 + q * 4 + 1] = t.y; cx[j * 16 + q * 4 + 2] = t.z; cx[j * 16 + q * 4 + 3] = t.w; } } };
    auto cvt_store = [&]() { if (crow < 2 * 16384) { const int which = crow >> 14, e = crow & 16383; float am = 0.f;
#pragma unroll
            for (int i = 0; i < 32; ++i) am += cx[i] * cx[i];
            am = wave_sum(am); const float dl = 0.3352f * sqrtf(am * (1.0f / 2048.0f)); const float inv = am > 0.f ? 1.0f / dl : 0.f, sc = am > 0.f ? dl : 1.0f;
            unsigned char* dst = ws + (which ? WS_V8 : WS_U8) + (size_t)e * 1024;
            v4u o;
#pragma unroll
            for (int k = 0; k < 4; ++k) { unsigned w = 0;
#pragma unroll
                for (int n = 0; n < 8; ++n) { int v = (int)floorf(cx[k * 8 + n] * inv); v = v < -8 ? -8 : (v > 7 ? 7 : v); w |= ((unsigned)v & 0xfu) << (4 * n); }
                o[k] = which ? (w ^ 0x08080808u) : w; }
            *(GAS v4u*)(dst + lane * 16) = o;
            if (lane == 0) ((float*)(ws + (which ? WS_SCV : WS_SCU)))[e] = sc; crow += cstride; } };
    if (!scanner) { issue(0); commit(0); }
    __syncthreads();
    if (scanner) __builtin_amdgcn_s_setprio(2);
    f32x4 S = {0.f, 0.f, 0.f, 0.f};
    constexpr int NST = SEQ / RTS;
    for (int st = 0; st < NST; ++st) { const int b2 = st & 1;
        if (scanner) {
        const LAS float* KK = sbuf(b2, 0) + 4 * jj; const LAS float* KKA = sbuf(b2, 1) + 4 * jj; const LAS float* W = sbuf(b2, 2) + 4 * jj; const LAS float* KP = sbuf(b2, 3) + 4 * jj; const LAS float* R = sbuf(b2, 4) + 4 * jj; const LAS float* V = sbuf(b2, 5) + irow;
        f32x4 nkk = *(const LAS f32x4*)KK, nkka = *(const LAS f32x4*)KKA, nw = *(const LAS f32x4*)W, nkp = *(const LAS f32x4*)KP, nr = *(const LAS f32x4*)R; float nv = V[0];
#pragma unroll
        for (int q = 0; q < RTS / 16; ++q) { float ysel = 0.f, yp = 0.f;
#pragma unroll
            for (int s16 = 0; s16 < 16; ++s16) { const int s = q * 16 + s16;
                const f32x4 kk = nkk, kka = nkka, wv = nw, kp = nkp, rr = nr; const float vi = nv;
                if (s + 1 < RTS) { nkk = *(const LAS f32x4*)(KK + (s + 1) * 64); nkka = *(const LAS f32x4*)(KKA + (s + 1) * 64); nw = *(const LAS f32x4*)(W + (s + 1) * 64); nkp = *(const LAS f32x4*)(KP + (s + 1) * 64); nr = *(const LAS f32x4*)(R + (s + 1) * 64); nv = V[(s + 1) * 64]; }
                float p = __builtin_fmaf(S.w, kk.w, __builtin_fmaf(S.z, kk.z, __builtin_fmaf(S.y, kk.y, S.x * kk.x)));
                const f32x4 t = kp * vi;
                if (s16 > 0) {
                    p += dppf<0x128>(p); yp += dppf<0x128>(yp); p += dppf<0x124>(p); yp += dppf<0x124>(yp);
                    p += dppf<0x122>(p); yp += dppf<0x122>(yp); p += dppf<0x121>(p); yp += dppf<0x121>(yp);
                    ysel = (s16 - 1 == jj) ? yp : ysel;
                } else p = rowsum16(p);
                S = S * wv + (t - kka * p);
                yp = __builtin_fmaf(S.w, rr.w, __builtin_fmaf(S.z, rr.z, __builtin_fmaf(S.y, rr.y, S.x * rr.x))); }
            yp = rowsum16(yp); ysel = (jj == 15) ? yp : ysel;
            Y[((size_t)b * SEQ + st * RTS + q * 16 + jj) * 1024 + h * 64 + irow] = (bf16)f2bf(ysel); }
        } else {
            if (st + 1 < NST) { issue(st + 1); commit(b2 ^ 1); }
            if (st & 1) cvt_store(); else cvt_load();
        }
        __syncthreads();
    }
    __builtin_amdgcn_s_setprio(0);
    if (!scanner) {
        if (NST & 1) cvt_store();
        while (crow < 2 * 16384) { cvt_load(); cvt_store(); } }
}
__device__ __forceinline__ void experts_convert(const Args& A, int bi, int nb, int tid) {
    unsigned char* ws = A.ws; const int lane = tid & 63, gw = bi * NWAVES + (tid >> 6), NGW = nb * NWAVES;
    for (int row = gw; row < 2 * 16384; row += NGW) { const int which = row >> 14, e = row & 16383;
        const float* src = A.in[23 + which] + (size_t)e * DM; float x[32];
#pragma unroll
        for (int j = 0; j < 2; ++j)
#pragma unroll
            for (int q = 0; q < 4; ++q) { const f32x4 t = *(const GAS f32x4*)(src + j * 1024 + lane * 16 + q * 4); x[j * 16 + q * 4] = t.x; x[j * 16 + q * 4 + 1] = t.y; x[j * 16 + q * 4 + 2] = t.z; x[j * 16 + q * 4 + 3] = t.w; }
        float am = 0.f;
#pragma unroll
        for (int i = 0; i < 32; ++i) am = fmaxf(am, fabsf(x[i]));
        am = wave_max(am); const float inv = am > 0.f ? 127.0f / am : 0.f, sc = am > 0.f ? am * (1.0f / 127.0f) : 1.0f;
        unsigned char* dst = ws + (which ? WS_V8 : WS_U8) + (size_t)e * DM;
#pragma unroll
        for (int j = 0; j < 2; ++j) { v4u o;
#pragma unroll
            for (int q = 0; q < 4; ++q) { unsigned w = 0;
#pragma unroll
                for (int bq = 0; bq < 4; ++bq) { int v = (int)rintf(x[j * 16 + q * 4 + bq] * inv); v = v < -127 ? -127 : (v > 127 ? 127 : v); w |= ((unsigned)v & 0xffu) << (8 * bq); }
                o[q] = w; }
            *(GAS v4u*)(dst + j * 1024 + lane * 16) = o; }
        if (lane == 0) ((float*)(ws + (which ? WS_SCV : WS_SCU)))[e] = sc; }
}

template <int PART> __device__ __forceinline__ void p4_post(const Args& A, int vcu, int G, int tid) {
    const int lane = tid & 63, wave = tid >> 6; unsigned char* ws = A.ws;
    const int gw = vcu * NWAVES + wave, NGW = G * NWAVES;
    const bf16* Oret = (const bf16*)(ws + WS_ORET); const bf16* Gb = (const bf16*)(ws + WS_GB); unsigned char* ORN = ws + WS_ORN; unsigned char* OWN = ws + WS_OWN; float* SAR = (float*)(ws + WS_SAR); float* SAW = (float*)(ws + WS_SAW);
    const bf16* Y = (const bf16*)(ws + WS_Y); const bf16* RKV = (const bf16*)(ws + WS_RKV); const bf16* Ab = (const bf16*)(ws + WS_AB); const bf16* Gg = (const bf16*)(ws + WS_GG);
    for (int n = gw; n < NTOK; n += NGW) {
        if (PART != 2) {
            const int c0 = (lane >> 4) * 256 + (lane & 15) * 16; float x[16], g[16];
            { const v4u a = *(const GAS v4u*)(Oret + (size_t)n * 1024 + c0), c = *(const GAS v4u*)(Oret + (size_t)n * 1024 + c0 + 8);
              x[0] = bflo(a.x); x[1] = bfhi(a.x); x[2] = bflo(a.y); x[3] = bfhi(a.y); x[4] = bflo(a.z); x[5] = bfhi(a.z); x[6] = bflo(a.w); x[7] = bfhi(a.w);
              x[8] = bflo(c.x); x[9] = bfhi(c.x); x[10] = bflo(c.y); x[11] = bfhi(c.y); x[12] = bflo(c.z); x[13] = bfhi(c.z); x[14] = bflo(c.w); x[15] = bfhi(c.w); }
            { const v4u a = *(const GAS v4u*)(Gb + (size_t)n * 1024 + c0), c = *(const GAS v4u*)(Gb + (size_t)n * 1024 + c0 + 8);
              g[0] = bflo(a.x); g[1] = bfhi(a.x); g[2] = bflo(a.y); g[3] = bfhi(a.y); g[4] = bflo(a.z); g[5] = bfhi(a.z); g[6] = bflo(a.w); g[7] = bfhi(a.w);
              g[8] = bflo(c.x); g[9] = bfhi(c.x); g[10] = bflo(c.y); g[11] = bfhi(c.y); g[12] = bflo(c.z); g[13] = bfhi(c.z); g[14] = bflo(c.w); g[15] = bfhi(c.w); }
            float s = 0.f;
#pragma unroll
            for (int i = 0; i < 16; ++i) s += x[i];
            const float mu = rowsum16(s) * (1.f / 256.f); float q = 0.f;
#pragma unroll
            for (int i = 0; i < 16; ++i) { x[i] -= mu; q += x[i] * x[i]; }
            const float rstd = 1.0f / sqrtf(rowsum16(q) * (1.f / 256.f) + 1e-6f);
            const float* gw_ = A.in[3] + c0; const float* gb_ = A.in[4] + c0; float am = 0.f;
#pragma unroll
            for (int i = 0; i < 16; ++i) { x[i] = (x[i] * rstd * gw_[i] + gb_[i]) * g[i]; am = fmaxf(am, fabsf(x[i])); }
            am = fmaxf(wave_max(am), 1e-30f); const float inv = 127.0f / am; v4u o;
#pragma unroll
            for (int i = 0; i < 4; ++i) o[i] = ((unsigned)(int)rintf(x[4 * i] * inv) & 0xffu) | (((unsigned)(int)rintf(x[4 * i + 1] * inv) & 0xffu) << 8) | (((unsigned)(int)rintf(x[4 * i + 2] * inv) & 0xffu) << 16) | (((unsigned)(int)rintf(x[4 * i + 3] * inv) & 0xffu) << 24);
            *(GAS v4u*)(ORN + (size_t)n * 1024 + c0) = o; if (lane == 0) SAR[n] = am * (1.0f / 127.0f);
        }
        if (PART != 1) {
            const int c0 = (lane >> 2) * 64 + (lane & 3) * 16; float y[16], r[16], k[16], v[16], a[16], g[16];
            { const v4u a_ = *(const GAS v4u*)(Y + (size_t)n * 1024 + c0), c_ = *(const GAS v4u*)(Y + (size_t)n * 1024 + c0 + 8);
              y[0] = bflo(a_.x); y[1] = bfhi(a_.x); y[2] = bflo(a_.y); y[3] = bfhi(a_.y); y[4] = bflo(a_.z); y[5] = bfhi(a_.z); y[6] = bflo(a_.w); y[7] = bfhi(a_.w);
              y[8] = bflo(c_.x); y[9] = bfhi(c_.x); y[10] = bflo(c_.y); y[11] = bfhi(c_.y); y[12] = bflo(c_.z); y[13] = bfhi(c_.z); y[14] = bflo(c_.w); y[15] = bfhi(c_.w); }
#define LD16(dst, ptr) do { const v4u a_ = *(const GAS v4u*)(ptr), c_ = *(const GAS v4u*)((ptr) + 8); \
            dst[0] = bflo(a_.x); dst[1] = bfhi(a_.x); dst[2] = bflo(a_.y); dst[3] = bfhi(a_.y); dst[4] = bflo(a_.z); dst[5] = bfhi(a_.z); dst[6] = bflo(a_.w); dst[7] = bfhi(a_.w); \
            dst[8] = bflo(c_.x); dst[9] = bfhi(c_.x); dst[10] = bflo(c_.y); dst[11] = bfhi(c_.y); dst[12] = bflo(c_.z); dst[13] = bfhi(c_.z); dst[14] = bflo(c_.w); dst[15] = bfhi(c_.w); } while (0)
            LD16(r, RKV + (size_t)n * 3072 + c0); LD16(k, RKV + (size_t)n * 3072 + 1024 + c0); LD16(v, RKV + (size_t)n * 3072 + 2048 + c0);
            LD16(a, Ab + (size_t)n * 1024 + c0); LD16(g, Gg + (size_t)n * 1024 + c0);
#undef LD16
            float s = 0.f;
#pragma unroll
            for (int i = 0; i < 16; ++i) s += y[i];
            const float mu = quadsum(s) * (1.f / 64.f); float q = 0.f;
#pragma unroll
            for (int i = 0; i < 16; ++i) { y[i] -= mu; q += y[i] * y[i]; }
            const float rstd = 1.0f / sqrtf(quadsum(q) * (1.f / 64.f) + 64e-5f);
            const float* ka = A.in[12] + c0; const float* rk = A.in[13] + c0; const float* lw = A.in[14] + c0; const float* lb = A.in[15] + c0;
            float bs = 0.f;
#pragma unroll
            for (int i = 0; i < 16; ++i) { const float kp = k[i] * (1.0f + (a[i] - 1.0f) * ka[i]); bs += r[i] * kp * rk[i]; }
            bs = quadsum(bs); float am = 0.f;
#pragma unroll
            for (int i = 0; i < 16; ++i) { y[i] = (y[i] * rstd * lw[i] + lb[i] + bs * v[i]) * g[i]; am = fmaxf(am, fabsf(y[i])); }
            am = fmaxf(wave_max(am), 1e-30f); const float inv = 127.0f / am; v4u o;
#pragma unroll
            for (int i = 0; i < 4; ++i) o[i] = ((unsigned)(int)rintf(y[4 * i] * inv) & 0xffu) | (((unsigned)(int)rintf(y[4 * i + 1] * inv) & 0xffu) << 8) | (((unsigned)(int)rintf(y[4 * i + 2] * inv) & 0xffu) << 16) | (((unsigned)(int)rintf(y[4 * i + 3] * inv) & 0xffu) << 24);
            *(GAS v4u*)(OWN + (size_t)n * 1024 + c0) = o; if (lane == 0) SAW[n] = am * (1.0f / 127.0f);
        }
    }
}

__device__ __forceinline__ float ub0(unsigned w) { return (float)(w & 0xffu); }
__device__ __forceinline__ float ub1(unsigned w) { return (float)((w >> 8) & 0xffu); }
__device__ __forceinline__ float ub2(unsigned w) { return (float)((w >> 16) & 0xffu); }
__device__ __forceinline__ float ub3(unsigned w) { return (float)(w >> 24); }
__device__ __forceinline__ float dpp_max_bcast15(float m) { const int b = __builtin_bit_cast(int, m); return fmaxf(m, __builtin_bit_cast(float, __builtin_amdgcn_update_dpp(b, b, 0x142, 0xa, 0xf, false))); }
__device__ __forceinline__ float dpp_max_bcast31(float m) { const int b = __builtin_bit_cast(int, m); return fmaxf(m, __builtin_bit_cast(float, __builtin_amdgcn_update_dpp(b, b, 0x143, 0xc, 0xf, false))); }
__device__ __forceinline__ float rdlane_f(float v, int l) { return __builtin_bit_cast(float, __builtin_amdgcn_readlane(__builtin_bit_cast(int, v), l)); }
__device__ __forceinline__ unsigned ord_key(float f) { const unsigned u = __builtin_bit_cast(unsigned, f); return (u & 0x80000000u) ? ~u : (u | 0x80000000u); }
__device__ __forceinline__ float ord_val(unsigned k) { const unsigned u = (k & 0x80000000u) ? (k & 0x7fffffffu) : ~k; return __builtin_bit_cast(float, u); }
__device__ __forceinline__ void peer_topk_radix_v(const float (&scv)[4], LAS float* wsc, int lane, int& expert, float& gate) {
    const int half = lane >> 5, l32 = lane & 31;
    unsigned key[4];
#pragma unroll
    for (int q = 0; q < 4; ++q) key[q] = (ord_key(scv[q]) & ~0x7fu) | (unsigned)(l32 + 32 * q);
    unsigned Pl = 0xBF800000u, Ph = 0xBF800000u; bool done = false;
    { int cl, ch;
#define PEER_CNT(tl_, th_) do { const unsigned trial_ = half ? (th_) : (tl_); \
        const unsigned long long m0 = __ballot(key[0] >= trial_), m1 = __ballot(key[1] >= trial_), m2 = __ballot(key[2] >= trial_), m3 = __ballot(key[3] >= trial_); \
        cl = __builtin_popcount((unsigned)m0) + __builtin_popcount((unsigned)m1) + __builtin_popcount((unsigned)m2) + __builtin_popcount((unsigned)m3); \
        ch = __builtin_popcount((unsigned)(m0 >> 32)) + __builtin_popcount((unsigned)(m1 >> 32)) + __builtin_popcount((unsigned)(m2 >> 32)) + __builtin_popcount((unsigned)(m3 >> 32)); } while (0)
      PEER_CNT(Pl, Ph);
      const bool upL = cl >= 16, upH = ch >= 16; bool doneL = false, doneH = false;
#pragma unroll 1
      for (int it = 0; it < 600 && !(doneL && doneH); ++it) { const unsigned tl = doneL ? Pl : (upL ? Pl + 0x800000u : Pl - 0x800000u), th = doneH ? Ph : (upH ? Ph + 0x800000u : Ph - 0x800000u);
          PEER_CNT(tl, th);
          if (!doneL) { if (upL) { if (cl >= 16) Pl = tl; else doneL = true; } else { Pl = tl; if (cl >= 16) doneL = true; } }
          if (!doneH) { if (upH) { if (ch >= 16) Ph = th; else doneH = true; } else { Ph = th; if (ch >= 16) doneH = true; } } }
    }
    unsigned K = half ? Ph : Pl;
    int cntL = 999, cntH = 999;
#pragma unroll 1
    for (int b = 22; b >= 0 && !done; --b) { const unsigned trial = K | (1u << b); int cl, ch;
        PEER_CNT(trial, trial);
        const bool al = cl >= 16, ah = ch >= 16;
        K = (half ? ah : al) ? trial : K;
        if (al) cntL = cl; if (ah) cntH = ch;
        if (cntL == 16 && cntH == 16) done = true; }
#undef PEER_CNT
    int base = 0;
#pragma unroll
    for (int q = 0; q < 4; ++q) { const bool sel = key[q] >= K; const unsigned long long m = __ballot(sel);
        const unsigned ml = (unsigned)m, mh = (unsigned)(m >> 32);
        const int below = half ? (int)__builtin_amdgcn_mbcnt_hi(mh, 0u) : (int)__builtin_amdgcn_mbcnt_lo(ml, 0u);
        const int p = base + below;
        if (sel) { wsc[half * 32 + p] = ord_val(key[q] & ~0x7fu); wsc[half * 32 + 16 + p] = __int_as_float((int)(key[q] & 0x7fu)); }
        base += __builtin_popcount(half ? mh : ml); }
    LDS_WAIT(); asm volatile("" ::: "memory");
    const int a = lane >> 2, b0 = 4 * (lane & 3);
    const float va = wsc[a]; unsigned ck[4];
#pragma unroll
    for (int q = 0; q < 4; ++q) ck[q] = (ord_key(va + wsc[32 + b0 + q]) & ~0xffu) | (unsigned)(a * 16 + b0 + q);
    unsigned K2 = 0xC0800000u;
    {
#define PEER_CNT2(t_) (__builtin_popcountll(__ballot(ck[0] >= (t_))) + __builtin_popcountll(__ballot(ck[1] >= (t_))) + __builtin_popcountll(__ballot(ck[2] >= (t_))) + __builtin_popcountll(__ballot(ck[3] >= (t_))))
      const bool up = PEER_CNT2(K2) >= 16; bool dn = false;
#pragma unroll 1
      for (int it = 0; it < 600 && !dn; ++it) { const unsigned t = up ? K2 + 0x800000u : K2 - 0x800000u; const int c = PEER_CNT2(t);
          if (up) { if (c >= 16) K2 = t; else dn = true; } else { K2 = t; if (c >= 16) dn = true; } }
#pragma unroll 1
      for (int b = 22; b >= 0; --b) { const unsigned trial = K2 | (1u << b); const int c = PEER_CNT2(trial);
          if (c >= 16) { K2 = trial; if (c == 16) break; } }
#undef PEER_CNT2
    }
    const int e1a = __float_as_int(wsc[16 + a]); int base2 = 0;
#pragma unroll
    for (int q = 0; q < 4; ++q) { const bool sel = ck[q] >= K2; const unsigned long long m = __ballot(sel);
        const int p = base2 + (int)__builtin_amdgcn_mbcnt_hi((unsigned)(m >> 32), __builtin_amdgcn_mbcnt_lo((unsigned)m, 0u));
        if (sel) { wsc[64 + p] = ord_val(ck[q] & ~0xffu); wsc[80 + p] = __int_as_float(e1a * 128 + __float_as_int(wsc[48 + b0 + q])); }
        base2 += (int)__builtin_popcountll(m); }
    LDS_WAIT(); asm volatile("" ::: "memory");
    const float gv = lane < 16 ? wsc[64 + lane] : -3.0e38f; expert = lane < 16 ? (__float_as_int(wsc[80 + lane]) & 16383) : 0;
    const float top = rowmax16(gv); const float e = lane < 16 ? __expf(gv - top) : 0.f; const float se = fmaxf(rowsum16(e), 1e-30f); gate = e / se;
    LDS_WAIT(); asm volatile("" ::: "memory");
}
__device__ __forceinline__ unsigned sel_u(unsigned a, unsigned b, int take) { return a ^ ((a ^ b) & (unsigned)(-take)); }
__device__ __forceinline__ void peer_topk_radix_w(const float (&s1)[2], const float (&s2)[2], LAS float* wsc, int lane, int& expert, float& gate) {
    unsigned k1[2], k2[2];
#pragma unroll
    for (int q = 0; q < 2; ++q) { k1[q] = (ord_key(s1[q]) & ~0x7fu) | (unsigned)(lane + 64 * q); k2[q] = (ord_key(s2[q]) & ~0x7fu) | (unsigned)(lane + 64 * q); }
#define PEER_C1(t_) ((int)__builtin_popcountll(__ballot(k1[0] >= (t_))) + (int)__builtin_popcountll(__ballot(k1[1] >= (t_))))
#define PEER_C2(t_) ((int)__builtin_popcountll(__ballot(k2[0] >= (t_))) + (int)__builtin_popcountll(__ballot(k2[1] >= (t_))))
    unsigned K1 = 0xBF800000u; int c1 = PEER_C1(K1);
    if (c1 >= 16) { for (;;) { const int n = PEER_C1(K1 + 0x800000u); if (n < 16) break; K1 += 0x800000u; c1 = n; } }
    else { do { K1 -= 0x800000u; c1 = PEER_C1(K1); } while (c1 < 16); }
#pragma unroll 1
    for (unsigned bit = 1u << 22; bit != 0u && c1 != 16; bit >>= 1) { const int n = PEER_C1(K1 | bit); if (n >= 16) { K1 |= bit; c1 = n; } }
    unsigned K2 = 0xBF800000u; int c2 = PEER_C2(K2);
    if (c2 >= 16) { for (;;) { const int n = PEER_C2(K2 + 0x800000u); if (n < 16) break; K2 += 0x800000u; c2 = n; } }
    else { do { K2 -= 0x800000u; c2 = PEER_C2(K2); } while (c2 < 16); }
#pragma unroll 1
    for (unsigned bit = 1u << 22; bit != 0u && c2 != 16; bit >>= 1) { const int n = PEER_C2(K2 | bit); if (n >= 16) { K2 |= bit; c2 = n; } }
#undef PEER_C1
#undef PEER_C2
    { int base = 0;
#pragma unroll
      for (int q = 0; q < 2; ++q) { const bool sel = k1[q] >= K1; const unsigned long long m = __ballot(sel);
          const int p = base + (int)__builtin_amdgcn_mbcnt_hi((unsigned)(m >> 32), __builtin_amdgcn_mbcnt_lo((unsigned)m, 0u));
          if (sel) { wsc[p] = ord_val(k1[q] & ~0x7fu); wsc[16 + p] = __int_as_float((int)(k1[q] & 0x7fu)); }
          base += (int)__builtin_popcountll(m); }
      base = 0;
#pragma unroll
      for (int q = 0; q < 2; ++q) { const bool sel = k2[q] >= K2; const unsigned long long m = __ballot(sel);
          const int p = base + (int)__builtin_amdgcn_mbcnt_hi((unsigned)(m >> 32), __builtin_amdgcn_mbcnt_lo((unsigned)m, 0u));
          if (sel) { wsc[32 + p] = ord_val(k2[q] & ~0x7fu); wsc[48 + p] = __int_as_float((int)(k2[q] & 0x7fu)); }
          base += (int)__builtin_popcountll(m); } }
    LDS_WAIT(); asm volatile("" ::: "memory");
    const int a = lane >> 2, b0 = 4 * (lane & 3);
    const float va = wsc[a]; unsigned ck[4];
#pragma unroll
    for (int q = 0; q < 4; ++q) ck[q] = (ord_key(va + wsc[32 + b0 + q]) & ~0xffu) | (unsigned)(a * 16 + b0 + q);
    unsigned K3 = 0xC0800000u; int c3;
    {
#define PEER_C3(t_) ((int)__builtin_popcountll(__ballot(ck[0] >= (t_))) + (int)__builtin_popcountll(__ballot(ck[1] >= (t_))) + (int)__builtin_popcountll(__ballot(ck[2] >= (t_))) + (int)__builtin_popcountll(__ballot(ck[3] >= (t_))))
      c3 = PEER_C3(K3);
      if (c3 >= 16) { for (;;) { const int n = PEER_C3(K3 + 0x800000u); if (n < 16) break; K3 += 0x800000u; c3 = n; } }
      else { do { K3 -= 0x800000u; c3 = PEER_C3(K3); } while (c3 < 16); }
#pragma unroll 1
      for (unsigned bit = 1u << 22; bit != 0u && c3 != 16; bit >>= 1) { const int n = PEER_C3(K3 | bit); if (n >= 16) { K3 |= bit; c3 = n; } }
#undef PEER_C3
    }
    const int e1a = __float_as_int(wsc[16 + a]); int base2 = 0;
#pragma unroll
    for (int q = 0; q < 4; ++q) { const bool sel = ck[q] >= K3; const unsigned long long m = __ballot(sel);
        const int p = base2 + (int)__builtin_amdgcn_mbcnt_hi((unsigned)(m >> 32), __builtin_amdgcn_mbcnt_lo((unsigned)m, 0u));
        if (sel) { wsc[64 + p] = ord_val(ck[q] & ~0xffu); wsc[80 + p] = __int_as_float(e1a * 128 + __float_as_int(wsc[48 + b0 + q])); }
        base2 += (int)__builtin_popcountll(m); }
    LDS_WAIT(); asm volatile("" ::: "memory");
    const float gv = lane < 16 ? wsc[64 + lane] : -3.0e38f; expert = lane < 16 ? (__float_as_int(wsc[80 + lane]) & 16383) : 0;
    const float top = rowmax16(gv); const float e = lane < 16 ? __expf(gv - top) : 0.f; const float se = fmaxf(rowsum16(e), 1e-30f); gate = e / se;
    LDS_WAIT(); asm volatile("" ::: "memory");
}
__device__ __forceinline__ void peer_topk_radix(const float* sc256, LAS float* wsc, int lane, int& expert, float& gate) {
    const float* sc = sc256 + (lane >> 5) * 128 + (lane & 31); const float scv[4] = {sc[0], sc[32], sc[64], sc[96]}; peer_topk_radix_v(scv, wsc, lane, expert, gate); }
__device__ __forceinline__ void peer_phase(const Args& A, LAS unsigned char* lds, int vcu, int G, int tid) {
    unsigned char* ws = A.ws;
    const int lane = tid & 63, hh = tid >> 6;
    const float* SC = (const float*)(ws + WS_SC); const bf16* H2 = (const bf16*)(ws + WS_H2); const unsigned char* U8 = ws + WS_U8; const unsigned char* V8 = ws + WS_V8;
    const float* SCU = (const float*)(ws + WS_SCU); const float* SCV = (const float*)(ws + WS_SCV);
    LAS float* red = (LAS float*)lds;
    LAS float* wsc = (LAS float*)(lds + 65536 + hh * 512);
    LAS float* bred = (LAS float*)(lds + 65536 + 4096);
    int ca = 0, cb = 0; bool cvalid = false;
    { int base = 0;
#pragma unroll
      for (int a = 0; a < 16; ++a) { const int cnt = 16 / (a + 1); if (lane >= base && lane < base + cnt) { ca = a; cb = lane - base; cvalid = true; } base += cnt; } }
    const int half = lane >> 5, l32 = lane & 31;
#define PEER_TOPK(n_, expert_, gate_, su_, sv_) do { \
        const float* sc = SC + (size_t)((n_) * 8 + hh) * 256 + half * 128 + l32; \
        float v[4] = {sc[0], sc[32], sc[64], sc[96]}; float tv = 0.f; int ti = 0; \
        _Pragma("unroll 1") for (int k = 0; k < 16; ++k) { \
            float m = fmaxf(fmaxf(v[0], v[1]), fmaxf(v[2], v[3])); float r = rowmax16(m); r = dpp_max_bcast15(r); \
            const float wm1 = rdlane_f(r, 31), wm2 = rdlane_f(r, 63), wm = half ? wm2 : wm1; \
            const unsigned long long mask = __ballot(m == wm); \
            const int o1 = (int)__builtin_ctz((unsigned)mask), o2 = 32 + (int)__builtin_ctz((unsigned)(mask >> 32)); \
            int qi = 3; if (v[2] == wm) qi = 2; if (v[1] == wm) qi = 1; if (v[0] == wm) qi = 0; \
            const int gi = l32 + 32 * qi; const int w1 = __builtin_amdgcn_readlane(gi, o1), w2 = __builtin_amdgcn_readlane(gi, o2); \
            if (lane == o1 || lane == o2) { v[0] = qi == 0 ? -3.0e38f : v[0]; v[1] = qi == 1 ? -3.0e38f : v[1]; v[2] = qi == 2 ? -3.0e38f : v[2]; v[3] = qi == 3 ? -3.0e38f : v[3]; } \
            if (l32 == k) { tv = wm; ti = half ? w2 : w1; } } \
        if (l32 < 16) { wsc[half * 32 + l32] = tv; wsc[half * 32 + 16 + l32] = __int_as_float(ti); } \
        LDS_WAIT(); asm volatile("" ::: "memory"); \
        float cs = cvalid ? wsc[ca] + wsc[32 + cb] : -3.0e38f; float gv = 0.f; int gc = 0; \
        _Pragma("unroll 1") for (int k = 0; k < 16; ++k) { \
            float r = rowmax16(cs); r = dpp_max_bcast15(r); r = dpp_max_bcast31(r); const float wm = rdlane_f(r, 63); \
            const int o = (int)__builtin_ctzll(__ballot(cs == wm)); if (lane == o) cs = -3.0e38f; if (lane == k) { gv = wm; gc = o; } } \
        const int sa_ = __builtin_amdgcn_ds_bpermute(4 * gc, ca), sb_ = __builtin_amdgcn_ds_bpermute(4 * gc, cb); \
        { const int a_ = lane < 16 ? sa_ : 0, b_ = lane < 16 ? sb_ : 0; const int e1 = __float_as_int(wsc[16 + a_]), e2 = __float_as_int(wsc[48 + b_]); expert_ = (e1 * 128 + e2) & 16383; \
          const float top0 = rdlane_f(gv, 0); const float e = (lane < 16) ? __expf(gv - top0) : 0.f; const float se = fmaxf(rowsum16(e), 1e-30f); gate_ = e / se; } \
        LDS_WAIT(); asm volatile("" ::: "memory"); \
        su_ = SCU[expert_]; sv_ = SCV[expert_]; } while (0)
#define PEER_LOADB(dst, TAB, expert_, kb) do { _Pragma("unroll") for (int i = 0; i < 8; ++i) { const int e = __builtin_amdgcn_readlane(expert_, (kb) * 8 + i); const unsigned char* rp = TAB + (size_t)e * DM + lane * 16; dst[i][0] = *(const GAS v4u*)rp; dst[i][1] = *(const GAS v4u*)(rp + 1024); } } while (0)
#define PEER_UDOT(src, kb) do { float z[8]; \
        _Pragma("unroll") for (int i = 0; i < 8; ++i) { int a0 = 0, a1 = 0; \
            _Pragma("unroll") for (int j = 0; j < 2; ++j) _Pragma("unroll") for (int q = 0; q < 4; q += 2) { a0 = __builtin_amdgcn_sdot4((int)src[i][j][q], xq8[j * 4 + q], a0, false); a1 = __builtin_amdgcn_sdot4((int)src[i][j][q + 1], xq8[j * 4 + q + 1], a1, false); } \
            z[i] = wave_sum((float)(a0 + a1)); } \
        _Pragma("unroll") for (int i = 0; i < 8; ++i) if (lane == (kb) * 8 + i) cact = gelu_erf(z[i] * su * sx) * gate * sv; } while (0)
#define PEER_VACC(src, kb) do { _Pragma("unroll") for (int g2 = 0; g2 < 2; ++g2) { const int cqg = cq4[(kb) * 2 + g2]; \
            _Pragma("unroll") for (int j = 0; j < 2; ++j) _Pragma("unroll") for (int q = 0; q < 4; ++q) { const unsigned w0 = src[g2 * 4][j][q], w1 = src[g2 * 4 + 1][j][q], w2 = src[g2 * 4 + 2][j][q], w3 = src[g2 * 4 + 3][j][q]; \
                const unsigned t01l = __builtin_amdgcn_perm(w1, w0, 0x05010400u), t01h = __builtin_amdgcn_perm(w1, w0, 0x07030602u), t23l = __builtin_amdgcn_perm(w3, w2, 0x05010400u), t23h = __builtin_amdgcn_perm(w3, w2, 0x07030602u); \
                const int xb = j * 16 + q * 4; \
                acc[xb]     = __builtin_amdgcn_sdot4((int)__builtin_amdgcn_perm(t23l, t01l, 0x05040100u), cqg, acc[xb], false); \
                acc[xb + 1] = __builtin_amdgcn_sdot4((int)__builtin_amdgcn_perm(t23l, t01l, 0x07060302u), cqg, acc[xb + 1], false); \
                acc[xb + 2] = __builtin_amdgcn_sdot4((int)__builtin_amdgcn_perm(t23h, t01h, 0x05040100u), cqg, acc[xb + 2], false); \
                acc[xb + 3] = __builtin_amdgcn_sdot4((int)__builtin_amdgcn_perm(t23h, t01h, 0x07060302u), cqg, acc[xb + 3], false); } } } while (0)
    int expert = 0; float gate = 0.f, su = 0.f, sv = 0.f;
    if (vcu < NTOK) { peer_topk_radix(SC + (size_t)(vcu * 8 + hh) * 256, wsc, lane, expert, gate); su = SCU[expert]; sv = SCV[expert]; }
    for (int n = vcu; n < NTOK; n += G) {
        v4u ra[8][2], rb[8][2];
        PEER_LOADB(ra, U8, expert, 0); PEER_LOADB(rb, U8, expert, 1);
        int xq8[8];
#pragma unroll
        for (int j = 0; j < 2; ++j) { const v4u t = *(const GAS v4u*)(ws + WS_H2Q + (size_t)n * DM + j * 1024 + lane * 16); xq8[j * 4] = (int)t.x; xq8[j * 4 + 1] = (int)t.y; xq8[j * 4 + 2] = (int)t.z; xq8[j * 4 + 3] = (int)t.w; }
        const float sx = ((const float*)(ws + WS_SX))[n];
        float cact = 0.f;
        PEER_UDOT(ra, 0);
        PEER_LOADB(ra, V8, expert, 0);
        PEER_UDOT(rb, 1);
        PEER_LOADB(rb, V8, expert, 1);
        int nexpert = 0; float ngate = 0.f, nsu = 0.f, nsv = 0.f;
        if (n + G < NTOK) { peer_topk_radix(SC + (size_t)((n + G) * 8 + hh) * 256, wsc, lane, nexpert, ngate); nsu = SCU[nexpert]; nsv = SCV[nexpert]; }
        int acc[32];
#pragma unroll
        for (int i = 0; i < 32; ++i) acc[i] = 0;
        const float cmax = fmaxf(rdlane_f(rowmax16(lane < 16 ? fabsf(cact) : 0.f), 0), 1e-30f); const float sc = cmax * (1.0f / 127.0f);
        const int cqk = (int)rintf(cact * (127.0f / cmax)) & 0xff;
        int cq4[4];
#pragma unroll
        for (int g = 0; g < 4; ++g) cq4[g] = __builtin_amdgcn_readlane(cqk, 4 * g) | (__builtin_amdgcn_readlane(cqk, 4 * g + 1) << 8) | (__builtin_amdgcn_readlane(cqk, 4 * g + 2) << 16) | (__builtin_amdgcn_readlane(cqk, 4 * g + 3) << 24);
        PEER_VACC(ra, 0); PEER_VACC(rb, 1);
#pragma unroll
        for (int j = 0; j < 2; ++j)
#pragma unroll
            for (int q = 0; q < 4; ++q) { const int xb = j * 16 + q * 4;
                *(LAS f32x4*)(red + hh * 2048 + j * 1024 + lane * 16 + q * 4) = (f32x4){(float)acc[xb] * sc, (float)acc[xb + 1] * sc, (float)acc[xb + 2] * sc, (float)acc[xb + 3] * sc}; }
        __syncthreads();
        f32x4 xs = *(const GAS f32x4*)(A.out + (size_t)n * DM + 4 * tid);
#pragma unroll
        for (int w8 = 0; w8 < 8; ++w8) xs = xs + *(const LAS f32x4*)(red + w8 * 2048 + 4 * tid);
        float ss = wave_sum((xs.x * xs.x + xs.y * xs.y) + (xs.z * xs.z + xs.w * xs.w));
        if (lane == 0) bred[hh] = ss;
        __syncthreads();
        float tot = 0.f;
#pragma unroll
        for (int w8 = 0; w8 < 8; ++w8) tot += bred[w8];
        const float r = 1.0f / sqrtf(tot * (1.f / 2048.f) + 1e-6f);
        const f32x4 fw = *(const GAS f32x4*)(A.in[25] + 4 * tid);
        *(GAS f32x4*)(A.out + (size_t)n * DM + 4 * tid) = xs * r * fw;
        __syncthreads();
        expert = nexpert; gate = ngate; su = nsu; sv = nsv;
    }
#undef PEER_TOPK
#undef PEER_LOADB
#undef PEER_UDOT
#undef PEER_VACC
}

template <int CTRL> __device__ __forceinline__ unsigned dppu(unsigned x) { return (unsigned)__builtin_amdgcn_update_dpp(0, (int)x, CTRL, 0xf, 0xf, false); }
__device__ __forceinline__ unsigned cexd(unsigned x, unsigned p, bool lower) { const unsigned mx = x > p ? x : p, mn = x > p ? p : x; return lower ? mx : mn; }
struct LaneBits { bool L1, L2, L4, L8; };
__device__ __forceinline__ unsigned dpp_xor4(unsigned x) { return dppu<0x1B>(dppu<0x141>(x)); }
__device__ __forceinline__ unsigned merge16(unsigned x, const LaneBits& B) { x = cexd(x, dppu<0x128>(x), B.L8); x = cexd(x, dpp_xor4(x), B.L4); x = cexd(x, dppu<0x4E>(x), B.L2); x = cexd(x, dppu<0xB1>(x), B.L1); return x; }
__device__ __forceinline__ unsigned sort16(unsigned x, const LaneBits& B) {
    x = cexd(x, dppu<0xB1>(x), B.L1);
    x = cexd(x, dppu<0x1B>(x), B.L2); x = cexd(x, dppu<0xB1>(x), B.L1);
    x = cexd(x, dppu<0x141>(x), B.L4); x = cexd(x, dppu<0x4E>(x), B.L2); x = cexd(x, dppu<0xB1>(x), B.L1);
    x = cexd(x, dppu<0x140>(x), B.L8); x = cexd(x, dpp_xor4(x), B.L4); x = cexd(x, dppu<0x4E>(x), B.L2); x = cexd(x, dppu<0xB1>(x), B.L1); return x; }
__device__ __forceinline__ unsigned top16_of_rows(unsigned x, int lane, const LaneBits& B) {
    unsigned p = (unsigned)__builtin_amdgcn_ds_bpermute((lane ^ 31) << 2, (int)x); x = x > p ? x : p; x = merge16(x, B);
    p = (unsigned)__builtin_amdgcn_ds_bpermute((lane ^ 47) << 2, (int)x); x = x > p ? x : p; x = merge16(x, B); return x; }
#define CEXV(ctrl_, L_) _Pragma("unroll") for (int i_ = 0; i_ < N; ++i_) x[i_] = cexd(x[i_], dppu<ctrl_>(x[i_]), L_)
#define CEXV4(L_) _Pragma("unroll") for (int i_ = 0; i_ < N; ++i_) x[i_] = cexd(x[i_], dpp_xor4(x[i_]), L_)
template <int N> __device__ __forceinline__ void merge16v(unsigned (&x)[N], const LaneBits& B) { CEXV(0x128, B.L8); CEXV4(B.L4); CEXV(0x4E, B.L2); CEXV(0xB1, B.L1); }
template <int N> __device__ __forceinline__ void sort16v(unsigned (&x)[N], const LaneBits& B) {
    CEXV(0xB1, B.L1);
    CEXV(0x1B, B.L2); CEXV(0xB1, B.L1);
    CEXV(0x141, B.L4); CEXV(0x4E, B.L2); CEXV(0xB1, B.L1);
    CEXV(0x140, B.L8); CEXV4(B.L4); CEXV(0x4E, B.L2); CEXV(0xB1, B.L1); }
template <int N> __device__ __forceinline__ void top16_of_rows_v(unsigned (&x)[N], int lane, const LaneBits& B) {
#pragma unroll
    for (int i = 0; i < N; ++i) { const unsigned p = (unsigned)__builtin_amdgcn_ds_bpermute((lane ^ 31) << 2, (int)x[i]); x[i] = x[i] > p ? x[i] : p; }
    merge16v<N>(x, B);
#pragma unroll
    for (int i = 0; i < N; ++i) { const unsigned p = (unsigned)__builtin_amdgcn_ds_bpermute((lane ^ 47) << 2, (int)x[i]); x[i] = x[i] > p ? x[i] : p; }
    merge16v<N>(x, B); }
#undef CEXV
#undef CEXV4
template <int NT> __device__ __forceinline__ void peer_topk_sort_w(const f32x4 (&sv)[NT], LAS float* wsc, int lane, int ca, int cb, bool cvalid, const LaneBits& B, int (&expert)[NT], float (&gate)[NT]) {
    unsigned k[4 * NT], c[NT];
#pragma unroll
    for (int t = 0; t < NT; ++t)
#pragma unroll
        for (int q = 0; q < 4; ++q) k[4 * t + q] = (ord_key(sv[t][q]) & ~0x7fu) | (unsigned)(4 * (lane & 31) + q);
    sort16v<4 * NT>(k, B);
    unsigned h[2 * NT];
#pragma unroll
    for (int i = 0; i < 2 * NT; ++i) { const unsigned m = dppu<0x140>(k[2 * i + 1]); h[i] = k[2 * i] > m ? k[2 * i] : m; }
    merge16v<2 * NT>(h, B);
    unsigned g[NT];
#pragma unroll
    for (int t = 0; t < NT; ++t) { const unsigned m = dppu<0x140>(h[2 * t + 1]); g[t] = h[2 * t] > m ? h[2 * t] : m; }
    merge16v<NT>(g, B);
#pragma unroll
    for (int t = 0; t < NT; ++t) { const unsigned p = (unsigned)__builtin_amdgcn_ds_bpermute((lane ^ 31) << 2, (int)g[t]); g[t] = g[t] > p ? g[t] : p; }
    merge16v<NT>(g, B);
#pragma unroll
    for (int t = 0; t < NT; ++t) if ((lane & 16) == 0) { LAS float* w = wsc + 64 * t + (lane & 32); w[lane & 15] = ord_val(g[t] & ~0x7fu); w[16 + (lane & 15)] = __int_as_float((int)(g[t] & 0x7fu)); }
    LDS_WAIT(); asm volatile("" ::: "memory");
#pragma unroll
    for (int t = 0; t < NT; ++t) { const LAS float* w = wsc + 64 * t; c[t] = cvalid ? ((ord_key(w[ca] + w[32 + cb]) & ~0xffu) | (unsigned)(ca * 16 + cb)) : 0u; }
    sort16v<NT>(c, B);
    top16_of_rows_v<NT>(c, lane, B);
#pragma unroll
    for (int t = 0; t < NT; ++t) { const LAS float* w = wsc + 64 * t; const int ia = (int)((c[t] >> 4) & 15u), ib = (int)(c[t] & 15u);
        const float gv = lane < 16 ? ord_val(c[t] & ~0xffu) : -3.0e38f; expert[t] = lane < 16 ? ((__float_as_int(w[16 + ia]) * 128 + __float_as_int(w[48 + ib])) & 16383) : 0;
        const float top = rowmax16(gv); const float e = lane < 16 ? __expf(gv - top) : 0.f; const float se = fmaxf(rowsum16(e), 1e-30f); gate[t] = e / se; }
    LDS_WAIT(); asm volatile("" ::: "memory");
}
__device__ __forceinline__ v4u ldrow(__amdgpu_buffer_rsrc_t tab, unsigned row, unsigned lane16) {
    return __builtin_amdgcn_raw_buffer_load_b128(tab, (int)lane16, __builtin_amdgcn_readfirstlane((int)(row << 10)), 0); }
#ifndef P3_LOG
#define P3_LOG 2
#endif
#ifndef P3_LOGU
#define P3_LOGU 2
#endif
__device__ __forceinline__ void peer_phase3(const Args& A, LAS unsigned char* lds, int vcu, int G, int bx, int tid) {
    unsigned char* ws = A.ws;
    const int lane = tid & 63, w = tid >> 6;
    const float* SC = (const float*)(ws + WS_SC); const unsigned char* U8 = ws + WS_U8; const unsigned char* V8 = ws + WS_V8;
    const float* SCU = (const float*)(ws + WS_SCU); const float* SCV = (const float*)(ws + WS_SCV);
    LAS unsigned short* EID = (LAS unsigned short*)(lds + w * 8192);
    LAS float* GATE = (LAS float*)(lds + w * 8192 + 1024);
    LAS float* ZL = (LAS float*)(lds + w * 8192 + 3072);
    LAS float* wsc = (LAS float*)(lds + w * 8192 + 5120);
    LAS unsigned* LIST = (LAS unsigned*)(lds + w * 8192 + 5632);
    LAS unsigned char* CQB = lds + w * 8192 + 6208;
    int ca = 0, cb = 0; bool cvalid = false;
    { int base = 0;
#pragma unroll
      for (int a = 0; a < 16; ++a) { const int cnt = 16 / (a + 1); if (lane >= base && lane < base + cnt) { ca = a; cb = lane - base; cvalid = true; } base += cnt; } }
    const int half = lane >> 5, l32 = lane & 31;
    const unsigned lane16 = (unsigned)lane * 16u;
    const __amdgpu_buffer_rsrc_t rsU = __builtin_amdgcn_make_buffer_rsrc((void*)U8, 0, 16384 * 1024, 0x00020000), rsV = __builtin_amdgcn_make_buffer_rsrc((void*)V8, 0, 16384 * 1024, 0x00020000);
    const bool lb3 = (lane & 8) != 0, lb2 = (lane & 4) != 0, lb1 = (lane & 2) != 0;
    const LaneBits LB{(lane & 1) == 0, (lane & 2) == 0, (lane & 4) == 0, (lane & 8) == 0};
    const int rot = (P3_LOG >= 3) ? ((1 << P3_LOG) / 8) * (bx & 7) : ((bx & 7) >> (3 - P3_LOG));
    const int rotu = (P3_LOGU >= 3) ? ((1 << P3_LOGU) / 8) * (bx & 7) : ((bx & 7) >> (3 - P3_LOGU));
    f32x4 nsc[2];
#pragma unroll
    for (int t = 0; t < 2; ++t) nsc[t] = *(const GAS f32x4*)(SC + (size_t)((vcu + G * w) * 8 + t) * 256 + 4 * lane);
#pragma unroll 1
    for (int task = 0; task < 32; task += 2) { const int tq = task >> 3, hd = task & 7;
        const f32x4 csv[2] = {nsc[0], nsc[1]};
        if (task + 2 < 32) {
#pragma unroll
            for (int t = 0; t < 2; ++t) { const int t1 = task + 2 + t; nsc[t] = *(const GAS f32x4*)(SC + (size_t)((vcu + G * (w + 8 * (t1 >> 3))) * 8 + (t1 & 7)) * 256 + 4 * lane); } }
        int expert[2]; float gate[2]; peer_topk_sort_w<2>(csv, wsc, lane, ca, cb, cvalid, LB, expert, gate);
        if (lane < 16) { EID[tq * 128 + hd * 16 + lane] = (unsigned short)expert[0]; GATE[tq * 128 + hd * 16 + lane] = gate[0]; EID[tq * 128 + (hd + 1) * 16 + lane] = (unsigned short)expert[1]; GATE[tq * 128 + (hd + 1) * 16 + lane] = gate[1]; }
        LDS_WAIT(); asm volatile("" ::: "memory");
    }
    unsigned idp[4]; int xh[4][4], xl[4][4]; float sx[4], sxh[4];
#pragma unroll
    for (int tq = 0; tq < 4; ++tq) { const int n = vcu + G * (w + 8 * tq); idp[tq] = (unsigned)EID[tq * 128 + lane] | ((unsigned)EID[tq * 128 + 64 + lane] << 16);
        const float pq = lane < 32 ? ((const float*)(ws + WS_PART))[(size_t)n * 32 + lane] : 0.f; const float rstd = 1.0f / sqrtf(wave_sum(pq) * (1.f / 2048.f) + 1e-6f);
        float xf[32]; float am = 0.f;
#pragma unroll
        for (int j = 0; j < 2; ++j)
#pragma unroll
            for (int q = 0; q < 2; ++q) { const v4u t = *(const GAS v4u*)((const bf16*)(ws + WS_X1B) + (size_t)n * DM + j * 1024 + lane * 16 + q * 8); const int xb = j * 16 + q * 8;
                const f32x4 w0 = *(const GAS f32x4*)(A.in[19] + j * 1024 + lane * 16 + q * 8), w1 = *(const GAS f32x4*)(A.in[19] + j * 1024 + lane * 16 + q * 8 + 4);
                xf[xb] = bflo(t.x) * w0.x; xf[xb + 1] = bfhi(t.x) * w0.y; xf[xb + 2] = bflo(t.y) * w0.z; xf[xb + 3] = bfhi(t.y) * w0.w; xf[xb + 4] = bflo(t.z) * w1.x; xf[xb + 5] = bfhi(t.z) * w1.y; xf[xb + 6] = bflo(t.w) * w1.z; xf[xb + 7] = bfhi(t.w) * w1.w; }
#pragma unroll
        for (int i = 0; i < 32; ++i) am = fmaxf(am, fabsf(xf[i]));
        am = fmaxf(wave_max(am), 1e-30f); const float inv = 119.0f / am; sx[tq] = am * rstd * (1.0f / 119.0f); int xsum = 0;
#pragma unroll
        for (int k = 0; k < 4; ++k) { unsigned ph = 0, pl = 0;
#pragma unroll
            for (int nn = 0; nn < 8; ++nn) { const int v = (int)rintf(xf[8 * k + nn] * inv); xsum += v; const int lo = ((v + 8) & 15) - 8, hi = (v - lo) >> 4; pl |= ((unsigned)lo & 0xfu) << (4 * nn); ph |= ((unsigned)hi & 0xfu) << (4 * nn); }
            xh[tq][k] = (int)ph; xl[tq][k] = (int)pl; }
        sxh[tq] = 0.5f * wave_sum((float)xsum); }
#define P3_ULOAD(buf_, b_) do { const v4u e0_ = *(const LAS v4u*)(LIST + 8 * (b_)), e1_ = *(const LAS v4u*)(LIST + 8 * (b_) + 4); const unsigned ee_[8] = {e0_.x, e0_.y, e0_.z, e0_.w, e1_.x, e1_.y, e1_.z, e1_.w}; \
        _Pragma("unroll") for (int i = 0; i < 8; ++i) buf_[i] = ldrow(rsU, ee_[i] & 0xffffu, lane16); } while (0)
#define P3_UCOMP(buf_, b_, tq_) do { int zi[8]; \
        _Pragma("unroll") for (int i = 0; i < 8; ++i) { int a0 = 0; \
            _Pragma("unroll") for (int k = 0; k < 4; ++k) a0 = __builtin_amdgcn_sdot8((int)buf_[i][k], xh[tq_][k], a0, false); \
            a0 <<= 4; \
            _Pragma("unroll") for (int k = 0; k < 4; ++k) a0 = __builtin_amdgcn_sdot8((int)buf_[i][k], xl[tq_][k], a0, false); \
            zi[i] = a0; } \
          \
        int t4[4], t2[2]; \
        _Pragma("unroll") for (int i = 0; i < 4; ++i) { const int keep = lb3 ? zi[i + 4] : zi[i], send = lb3 ? zi[i] : zi[i + 4]; t4[i] = keep + dppi<0x128>(send); } \
        _Pragma("unroll") for (int i = 0; i < 2; ++i) { const int keep = lb2 ? t4[i + 2] : t4[i], send = lb2 ? t4[i] : t4[i + 2]; t2[i] = keep + dppi<0x141>(send); } \
        int zs; { const int keep = lb1 ? t2[1] : t2[0], send = lb1 ? t2[0] : t2[1]; zs = keep + dppi<0x4E>(send); } \
        zs += dppi<0xB1>(zs); \
        zs += __shfl_xor(zs, 16); zs += __shfl_xor(zs, 32); \
        const unsigned mye_ = LIST[8 * (b_) + ((lane >> 1) & 7)]; if (lane < 16 && !(lane & 1) && (mye_ >> 16) < 128u) ZL[(tq_) * 128 + (int)(mye_ >> 16)] = (float)zs; } while (0)
#pragma unroll 1
    for (int r = 0; r < (1 << P3_LOGU); ++r) { const int s = (r + rotu) & ((1 << P3_LOGU) - 1);
        __syncthreads();
#pragma unroll
        for (int tq = 0; tq < 4; ++tq) { const int id0 = (int)(idp[tq] & 0xffffu), id1 = (int)(idp[tq] >> 16);
            const bool s0 = (id0 >> (14 - P3_LOGU)) == s, s1 = (id1 >> (14 - P3_LOGU)) == s;
            const unsigned long long m0 = __ballot(s0), m1 = __ballot(s1); const int c0 = (int)__builtin_popcountll(m0), cnt = c0 + (int)__builtin_popcountll(m1), nb = ((cnt + 3) >> 2) >> 1, tail = ((cnt + 3) >> 2) & 1;
            if (s0) LIST[__builtin_amdgcn_mbcnt_hi((unsigned)(m0 >> 32), __builtin_amdgcn_mbcnt_lo((unsigned)m0, 0u))] = (unsigned)id0 | ((unsigned)lane << 16);
            if (s1) LIST[c0 + __builtin_amdgcn_mbcnt_hi((unsigned)(m1 >> 32), __builtin_amdgcn_mbcnt_lo((unsigned)m1, 0u))] = (unsigned)id1 | ((unsigned)(64 + lane) << 16);
            if (lane < 4 && cnt + lane < 4 * ((cnt + 3) >> 2)) LIST[cnt + lane] = (unsigned)(s << (14 - P3_LOGU)) | (0xffu << 16);
            LDS_WAIT(); asm volatile("" ::: "memory");
            v4u ua[8], ub[8];
            if (nb > 0) P3_ULOAD(ua, 0);
#pragma unroll 1
            for (int b = 0; b < nb; b += 2) {
                if (b + 1 < nb) P3_ULOAD(ub, b + 1);
                P3_UCOMP(ua, b, tq);
                if (b + 1 < nb) { if (b + 2 < nb) P3_ULOAD(ua, b + 2); P3_UCOMP(ub, b + 1, tq); } }
            if (tail) {
                const v4u e_ = *(const LAS v4u*)(LIST + 8 * nb); const unsigned ee_[4] = {e_.x, e_.y, e_.z, e_.w}; v4u ut[4];
#pragma unroll
                for (int i = 0; i < 4; ++i) ut[i] = ldrow(rsU, ee_[i] & 0xffffu, lane16);
                int t4[4];
#pragma unroll
                for (int i = 0; i < 4; ++i) { int a0 = 0;
#pragma unroll
                    for (int k = 0; k < 4; ++k) a0 = __builtin_amdgcn_sdot8((int)ut[i][k], xh[tq][k], a0, false);
                    a0 <<= 4;
#pragma unroll
                    for (int k = 0; k < 4; ++k) a0 = __builtin_amdgcn_sdot8((int)ut[i][k], xl[tq][k], a0, false);
                    t4[i] = a0 + dppi<0x128>(a0); }
                int t2[2];
#pragma unroll
                for (int i = 0; i < 2; ++i) { const int keep = lb2 ? t4[i + 2] : t4[i], send = lb2 ? t4[i] : t4[i + 2]; t2[i] = keep + dppi<0x141>(send); }
                int zs; { const int keep = lb1 ? t2[1] : t2[0], send = lb1 ? t2[0] : t2[1]; zs = keep + dppi<0x4E>(send); }
                zs += dppi<0xB1>(zs);
                zs += __shfl_xor(zs, 16); zs += __shfl_xor(zs, 32);
                const unsigned mye_ = LIST[8 * nb + ((lane >> 1) & 3)]; if (lane < 8 && !(lane & 1) && (mye_ >> 16) < 128u) ZL[tq * 128 + (int)(mye_ >> 16)] = (float)zs; }
            LDS_WAIT(); asm volatile("" ::: "memory"); } }
#undef P3_ULOAD
#undef P3_UCOMP
    LDS_WAIT(); asm volatile("" ::: "memory");
    unsigned cqp[4]; float scv[4], k1f[4];
#pragma unroll
    for (int tq = 0; tq < 4; ++tq) { const int id0 = (int)(idp[tq] & 0xffffu), id1 = (int)(idp[tq] >> 16);
        const float z0 = ZL[tq * 128 + lane], z1 = ZL[tq * 128 + 64 + lane], g0 = GATE[tq * 128 + lane], g1 = GATE[tq * 128 + 64 + lane];
        const float c0 = gelu_erf((z0 + sxh[tq]) * SCU[id0] * sx[tq]) * g0 * SCV[id0], c1 = gelu_erf((z1 + sxh[tq]) * SCU[id1] * sx[tq]) * g1 * SCV[id1];
        const float cmax = fmaxf(wave_max(fmaxf(fabsf(c0), fabsf(c1))), 1e-30f), inv = 127.0f / cmax; const int q0 = (int)rintf(c0 * inv), q1 = (int)rintf(c1 * inv);
        cqp[tq] = ((unsigned)q0 & 0xffu) | (((unsigned)q1 & 0xffu) << 8); scv[tq] = cmax * (1.0f / 127.0f); k1f[tq] = wave_sum((float)(q0 + q1)); }
    int accA[4][16], accL[4][16];
#pragma unroll
    for (int tq = 0; tq < 4; ++tq)
#pragma unroll
        for (int i = 0; i < 16; ++i) { accA[tq][i] = 0; accL[tq][i] = 0; }
#define P3_VLOAD(buf_, g_) do { const v4u e_ = *(const LAS v4u*)(LIST + 4 * (g_)); const unsigned ee_[4] = {e_.x, e_.y, e_.z, e_.w}; \
        _Pragma("unroll") for (int i = 0; i < 4; ++i) buf_[i] = ldrow(rsV, ee_[i], lane16); } while (0)
#define P3_VCOMP(buf_, g_, tq_) do { const int cqg_ = (int)*(const LAS unsigned*)(CQB + 4 * (g_)); \
        _Pragma("unroll") for (int k = 0; k < 4; ++k) { const unsigned w0 = buf_[0][k], w1 = buf_[1][k], w2 = buf_[2][k], w3 = buf_[3][k]; \
            const unsigned t01l = __builtin_amdgcn_perm(w1, w0, 0x05010400u), t01h = __builtin_amdgcn_perm(w1, w0, 0x07030602u), t23l = __builtin_amdgcn_perm(w3, w2, 0x05010400u), t23h = __builtin_amdgcn_perm(w3, w2, 0x07030602u); \
            const unsigned T0 = __builtin_amdgcn_perm(t23l, t01l, 0x05040100u), T1 = __builtin_amdgcn_perm(t23l, t01l, 0x07060302u), T2 = __builtin_amdgcn_perm(t23h, t01h, 0x05040100u), T3 = __builtin_amdgcn_perm(t23h, t01h, 0x07060302u); \
            const int xb = k * 4; \
            accA[tq_][xb]     = __builtin_amdgcn_sdot4((int)T0, cqg_, accA[tq_][xb], false);     accL[tq_][xb]     = __builtin_amdgcn_sdot4((int)(T0 & 0x0f0f0f0fu), cqg_, accL[tq_][xb], false); \
            accA[tq_][xb + 1] = __builtin_amdgcn_sdot4((int)T1, cqg_, accA[tq_][xb + 1], false); accL[tq_][xb + 1] = __builtin_amdgcn_sdot4((int)(T1 & 0x0f0f0f0fu), cqg_, accL[tq_][xb + 1], false); \
            accA[tq_][xb + 2] = __builtin_amdgcn_sdot4((int)T2, cqg_, accA[tq_][xb + 2], false); accL[tq_][xb + 2] = __builtin_amdgcn_sdot4((int)(T2 & 0x0f0f0f0fu), cqg_, accL[tq_][xb + 2], false); \
            accA[tq_][xb + 3] = __builtin_amdgcn_sdot4((int)T3, cqg_, accA[tq_][xb + 3], false); accL[tq_][xb + 3] = __builtin_amdgcn_sdot4((int)(T3 & 0x0f0f0f0fu), cqg_, accL[tq_][xb + 3], false); } } while (0)
#pragma unroll 1
    for (int r = 0; r < (1 << P3_LOG); ++r) { const int s = (r + rot) & ((1 << P3_LOG) - 1);
        __syncthreads();
#pragma unroll
        for (int tq = 0; tq < 4; ++tq) { const int id0 = (int)(idp[tq] & 0xffffu), id1 = (int)(idp[tq] >> 16); const int cq0 = (int)(cqp[tq] & 0xffu), cq1 = (int)((cqp[tq] >> 8) & 0xffu);
            const bool s0 = (id0 >> (14 - P3_LOG)) == s, s1 = (id1 >> (14 - P3_LOG)) == s;
            const unsigned long long m0 = __ballot(s0), m1 = __ballot(s1); const int c0 = (int)__builtin_popcountll(m0), cnt = c0 + (int)__builtin_popcountll(m1), ng = (cnt + 3) >> 2;
            { const int p0 = (int)__builtin_amdgcn_mbcnt_hi((unsigned)(m0 >> 32), __builtin_amdgcn_mbcnt_lo((unsigned)m0, 0u)), p1 = c0 + (int)__builtin_amdgcn_mbcnt_hi((unsigned)(m1 >> 32), __builtin_amdgcn_mbcnt_lo((unsigned)m1, 0u));
              if (s0) { LIST[p0] = (unsigned)id0; CQB[p0] = (unsigned char)cq0; }
              if (s1) { LIST[p1] = (unsigned)id1; CQB[p1] = (unsigned char)cq1; }
              if (lane < 4 && cnt + lane < 4 * ng) { LIST[cnt + lane] = (unsigned)(s << (14 - P3_LOG)); CQB[cnt + lane] = 0; } }
            LDS_WAIT(); asm volatile("" ::: "memory");
            v4u va[4], vb[4];
            if (ng > 0) P3_VLOAD(va, 0);
#pragma unroll 1
            for (int g = 0; g < ng; g += 2) {
                if (g + 1 < ng) P3_VLOAD(vb, g + 1);
                P3_VCOMP(va, g, tq);
                if (g + 1 < ng) { if (g + 2 < ng) P3_VLOAD(va, g + 2); P3_VCOMP(vb, g + 1, tq); } }
            LDS_WAIT(); asm volatile("" ::: "memory"); } }
#undef P3_VLOAD
#undef P3_VCOMP
#pragma unroll
    for (int tq = 0; tq < 4; ++tq) { const int n = vcu + G * (w + 8 * tq); float xs[32]; float ss = 0.f;
#pragma unroll
        for (int j = 0; j < 2; ++j)
#pragma unroll
            for (int q = 0; q < 4; ++q) { const v2u tb = *(const GAS v2u*)((const bf16*)(ws + WS_X1B) + (size_t)n * DM + j * 1024 + lane * 16 + q * 4); const f32x4 t = {bflo(tb.x), bfhi(tb.x), bflo(tb.y), bfhi(tb.y)}; const int xb = j * 16 + q * 4;
                const int y0 = xb >> 1, y1 = y0 + 1; const float ke = -7.5f * k1f[tq], ko = 0.5f * k1f[tq];
                xs[xb] = t.x + ((float)accL[tq][y0] + ke) * scv[tq]; xs[xb + 1] = t.y + ((float)(accA[tq][y0] - accL[tq][y0]) * 0.0625f + ko) * scv[tq];
                xs[xb + 2] = t.z + ((float)accL[tq][y1] + ke) * scv[tq]; xs[xb + 3] = t.w + ((float)(accA[tq][y1] - accL[tq][y1]) * 0.0625f + ko) * scv[tq];
                ss += (xs[xb] * xs[xb] + xs[xb + 1] * xs[xb + 1]) + (xs[xb + 2] * xs[xb + 2] + xs[xb + 3] * xs[xb + 3]); }
        const float rr = 1.0f / sqrtf(wave_sum(ss) * (1.f / 2048.f) + 1e-6f);
#pragma unroll
        for (int j = 0; j < 2; ++j)
#pragma unroll
            for (int q = 0; q < 4; ++q) { const int xb = j * 16 + q * 4; const f32x4 fw = *(const GAS f32x4*)(A.in[25] + j * 1024 + lane * 16 + q * 4);
                *(GAS f32x4*)(A.out + (size_t)n * DM + j * 1024 + lane * 16 + q * 4) = (f32x4){xs[xb] * rr * fw.x, xs[xb + 1] * rr * fw.y, xs[xb + 2] * rr * fw.z, xs[xb + 3] * rr * fw.w}; } }
}

constexpr int NPHASE = 12;
#ifndef USE_CG
#define USE_CG 0
#endif
__global__ void __launch_bounds__(NTHR, 2) fwd_kernel(Args args) {
    extern __shared__ __attribute__((aligned(16))) unsigned char lds_raw[];
    LAS unsigned char* lds = (LAS unsigned char*)lds_raw;
    const int tid = threadIdx.x, G = gridDim.x, bx = blockIdx.x;
    const int vcu = (G % 8 == 0) ? (bx % 8) * (G / 8) + bx / 8 : bx;
    unsigned char* ws = args.ws;
    for (int u = tid; u < (LDS_BYTES - LDSCTL_OFF) / 4; u += NTHR) ((LAS unsigned*)(lds + LDSCTL_OFF))[u] = 0u;
    __syncthreads();
    const int lo = args.ph_lo, hi = args.ph_hi;
    const bool use_bar = (hi - lo) > 1;
    XcdBarrier bar; bar.bar = (unsigned*)(ws + WS_CTL) + CW_BAR; bar.x = 0; bar.st = nullptr;
    if (use_bar && !USE_CG) bar = xcd_barrier_post((unsigned*)(ws + WS_CTL) + CW_BAR, (volatile LAS unsigned*)(lds + MISC_OFF) + 8);
#ifndef PHMASK
#define PHMASK 0xfff
#endif
#define IN(k) (((PHMASK >> (k)) & 1) && lo <= (k) && (k) < hi)
#if USE_CG
#define SEAM(k) do { if (IN(k) && IN((k) + 1)) { __syncthreads(); cooperative_groups::this_grid().sync(); } } while (0)
#else
#define SEAM(k) do { if (IN(k) && IN((k) + 1)) xcd_barrier(bar); } while (0)
#endif
    typedef pg8::bf16_t pb;
    if (IN(0)) { p0_win_strip(args, lds, bx, tid);
        p0_prologue(args, lds, vcu, G, tid); VM_WAIT(); __syncthreads(); } SEAM(0);
    constexpr int P1_TILES = 32;
    if (IN(1)) { pg8::Gemm g{(const pb*)(ws + WS_H), (const pb*)(ws + WS_WIN), NTOK, P1_TILES * 256, DM / 2}; pg8::StaticOrder S; S.init(NTOK, P1_TILES * 256, G, bx);
        pg8::EpiZ E{(pb*)(ws + WS_QB), (pb*)(ws + WS_KB), (pb*)(ws + WS_VR), (pb*)(ws + WS_GB), (pb*)(ws + WS_ZR), (pb*)(ws + WS_SG), (const float*)(ws + WS_ROT), (const float*)(ws + WS_ROT) + 4096 * 128, (const float*)(ws + WS_SA), (const unsigned*)(ws + WS_CTL + WS_SBM)};
        pg8::gemm_phase<pg8::EpiZ, pg8::StaticOrder, true, true, true>(lds, g, S, E); } SEAM(1);
    constexpr int P4_TILES = 12;
    if (IN(2)) {
        p2a_lerp(args, vcu, G, tid);
        VM_WAIT(); __syncthreads(); } SEAM(2);
    if (IN(3)) { int k256 = 256; asm volatile("" : "+s"(k256)); pg8::Gemm g{(const pb*)(ws + WS_L), (const pb*)(ws + WS_WLORA), NTOK, 3072, k256}; pg8::LoraOrder S{bx};
        pg8::EpiLora E{(float*)(ws + WS_DEC), (pb*)(ws + WS_AB), (pb*)(ws + WS_GG), args.in[6], args.in[8]};
        pg8::gemm_phase<pg8::EpiLora, pg8::LoraOrder, true, true>(lds, g, S, E);
        p4_w_absmax(args, bx, G, tid);
} SEAM(3);
    if (IN(4)) { const int grp = bx >> 3, xi = bx & 7;
        if (grp >= 8 && grp < 24) { const int g = grp - 8; rwkv_scan_unit(args, lds, (g >> 2) * 8 + xi, g & 3, g * 8 + xi, 128, tid); }
        else { const int gi = grp < 8 ? bx : bx - 128; constexpr int NG = 128; unsigned* gcnt = (unsigned*)(ws + WS_CTL) + CW_GBAR;
            if (gi < IN_COLS / 32 - 256) p0_win_strip(args, lds, 256 + gi, tid);
            group_barrier(gcnt + 96, NG, tid);
            { pg8::Gemm g{(const pb*)(ws + WS_H), (const pb*)(ws + WS_WIN), NTOK, IN_COLS, DM / 2}; pg8::SubOrder S{NTOK / 256, P4_TILES, P1_TILES, NG, gi};
              pg8::EpiZ E{(pb*)(ws + WS_QB), (pb*)(ws + WS_KB), (pb*)(ws + WS_VR), (pb*)(ws + WS_GB), (pb*)(ws + WS_ZR), (pb*)(ws + WS_SG), (const float*)(ws + WS_ROT), (const float*)(ws + WS_ROT) + 4096 * 128, (const float*)(ws + WS_SA), (const unsigned*)(ws + WS_CTL + WS_SBM)};
              pg8::gemm_phase<pg8::EpiZ, pg8::SubOrder, true, true, true>(lds, g, S, E); }
            const int nslow = P4_TILES * 32 - 3 * NG;
            const int u0 = gi < nslow ? gi : nslow + (gi - nslow) * ((512 - nslow) / (NG - nslow)), un = gi < nslow ? 1 : (512 - nslow) / (NG - nslow);
            p4_wq_copy(args, gi, NG, tid);
            ret_units_a3(args, lds, u0, un, tid);
            group_barrier(gcnt, NG, tid);
            ret_scan_b(args, gi, NG, tid);
            group_barrier(gcnt, 2 * NG, tid);
            for (int u = u0; u < u0 + un; ++u) ret_unit_c(args, u >> 6, u & 63, tid);
            __syncthreads();
            { int k256b = 256; asm volatile("" : "+s"(k256b)); pg8::Gemm g2{(const pb*)(ws + WS_KEYS), (const pb*)(ws + WS_WQ), 256, 8 * 2048, k256b}; pg8::StaticOrder S2; S2.init(256, 8 * 2048, NG, gi);
              pg8::EpiGen<5> E2{nullptr, 0, nullptr, (pb*)(ws + WS_WQK), nullptr, 0};
              pg8::gemm_phase<pg8::EpiGen<5>, pg8::StaticOrder, true, true>(lds, g2, S2, E2); }
            VM_WAIT(); __syncthreads(); p4_weight_transposes(args, lds, gi, NG, tid);
            VM_WAIT(); __syncthreads();
            { pg8::Gemm g{(const pb*)(ws + WS_H), (const pb*)(ws + WS_WIN), NTOK, IN_COLS, DM / 2}; pg8::SubOrder S{NTOK / 256, 1, P1_TILES + P4_TILES, NG, gi};
              pg8::EpiZ E{(pb*)(ws + WS_QB), (pb*)(ws + WS_KB), (pb*)(ws + WS_VR), (pb*)(ws + WS_GB), (pb*)(ws + WS_ZR), (pb*)(ws + WS_SG), (const float*)(ws + WS_ROT), (const float*)(ws + WS_ROT) + 4096 * 128, (const float*)(ws + WS_SA), (const unsigned*)(ws + WS_CTL + WS_SBM)};
              pg8::gemm_phase<pg8::EpiZ, pg8::SubOrder, true, true, true>(lds, g, S, E); }
            group_barrier(gcnt + 32, NG, tid);
            p4_post<1>(args, gi, NG, tid);
            group_barrier(gcnt + 64, NG, tid);
            { pg8::StaticOrder S6; S6.init(NTOK, DM, NG, gi);
              pg8::Gemm g6{(const pb*)(ws + WS_ORN), (const pb*)(ws + WS_WR), NTOK, DM, RW / 2}; pg8::EpiGen<0> E6{(const pb*)(ws + WS_SG), 0, (float*)(ws + WS_M1), nullptr, nullptr, 0, (const float*)(ws + WS_SAR), (const unsigned*)(ws + WS_CTL + WS_SBRW)};
              pg8::gemm_phase<pg8::EpiGen<0>, pg8::StaticOrder, true, true, true>(lds, g6, S6, E6); } }
        VM_WAIT(); __syncthreads(); } SEAM(4);
    if (IN(5)) { p4_post<2>(args, vcu, G, tid); VM_WAIT(); __syncthreads(); } SEAM(5);
    if (IN(6)) { pg8::StaticOrder S; S.init(NTOK, DM, G, bx);
        { pg8::Gemm g{(const pb*)(ws + WS_OWN), (const pb*)(ws + WS_WW), NTOK, DM, RW / 2}; pg8::EpiGen<1> E{(const pb*)(ws + WS_SG), 2048, (float*)(ws + WS_M1), (pb*)(ws + WS_MG), nullptr, 0, (const float*)(ws + WS_SAW), (const unsigned*)(ws + WS_CTL + WS_SBRW) + 2048};
          pg8::gemm_phase<pg8::EpiGen<1>, pg8::StaticOrder, true, true, true>(lds, g, S, E); } } SEAM(6);
    if (IN(7)) { pg8::Gemm g{(const pb*)(ws + WS_MG), (const pb*)(ws + WS_WO), NTOK, DM, DM}; pg8::StaticOrder S; S.init(NTOK, DM, G, bx);
        pg8::EpiX1 E{args.in[0], (pb*)(ws + WS_X1B), (pb*)(ws + WS_H2), args.in[19], (float*)(ws + WS_PART)};
        pg8::gemm_phase<pg8::EpiX1, pg8::StaticOrder, true, true>(lds, g, S, E); } SEAM(7);
    if (IN(9)) { pg8::Gemm g{(const pb*)(ws + WS_X1B), (const pb*)(ws + WS_WQK), NTOK, DM, DM}; pg8::StaticOrder S; S.init(NTOK, DM, G, bx);
        LAS float* rtab = (LAS float*)(lds + LDSCTL_OFF + 1024);
        { pg8::Unit u0; if (S.next(0, u0)) { const int row = tid >> 1, hq = tid & 1; const float* pp = (const float*)(ws + WS_PART) + (size_t)(u0.pm * 256 + row) * 32 + 16 * hq; float sq = 0.f;
#pragma unroll
              for (int q = 0; q < 4; ++q) { const f32x4 t = *(const GAS f32x4*)(pp + 4 * q); sq += (t.x + t.y) + (t.z + t.w); }
              sq += __shfl_xor(sq, 1); if (hq == 0) rtab[row] = 1.0f / sqrtf(sq * (1.f / 2048.f) + 1e-6f); } }
        __syncthreads();
        pg8::EpiScore E{(float*)(ws + WS_SC), (const LAS float*)rtab};
        pg8::gemm_phase<pg8::EpiScore, pg8::StaticOrder, true, true>(lds, g, S, E); }
    SEAM(10);
#ifndef PEER_V3
#define PEER_V3 1
#endif
    if (IN(11)) { if (PEER_V3) peer_phase3(args, lds, vcu, G, use_bar ? (int)bar.x : bx, tid); else peer_phase(args, lds, vcu, G, tid); }
#undef IN
#undef SEAM
}

#ifndef MK_PER_PHASE
#define MK_PER_PHASE 0
#endif
extern "C" void kernel_launch(void* const* d_in, const int* in_sizes, int n_in, void* d_out, int out_size, void* d_ws, size_t ws_size, hipStream_t stream) {
    static int grid = 0;
    if (grid == 0) {
        if (n_in != 26 || in_sizes[0] != NTOK * DM || out_size != NTOK * DM || ws_size < WS_END) {
            fprintf(stderr, "kernel_launch: unexpected problem: n_in %d in0 %d out %d ws %zu (need %zu); nothing launched\n", n_in, n_in > 0 ? in_sizes[0] : -1, out_size, ws_size, (size_t)WS_END); grid = -1; return; }
        int dev = 0, cus = 0, per_cu = 0;
        if (hipGetDevice(&dev) != hipSuccess || hipDeviceGetAttribute(&cus, hipDeviceAttributeMultiprocessorCount, dev) != hipSuccess) { fprintf(stderr, "kernel_launch: device query failed\n"); grid = -1; return; }
        if (hipFuncSetAttribute((const void*)fwd_kernel, hipFuncAttributeMaxDynamicSharedMemorySize, LDS_BYTES) != hipSuccess) { fprintf(stderr, "kernel_launch: hipFuncSetAttribute failed\n"); grid = -1; return; }
        if (hipOccupancyMaxActiveBlocksPerMultiprocessor(&per_cu, (const void*)fwd_kernel, NTHR, LDS_BYTES) != hipSuccess || per_cu < 1) { fprintf(stderr, "kernel_launch: occupancy query says %d blocks/CU; nothing launched\n", per_cu); (void)hipGetLastError(); grid = -1; return; }
        grid = cus;
        if (grid != 256) { fprintf(stderr, "kernel_launch: built for a 256-CU device, found %d CUs; nothing launched\n", cus); grid = -1; return; }
    }
    if (grid < 0) return;
    if (hipMemsetAsync((char*)d_ws + WS_CTL, 0, CTL_ZERO_BYTES, stream) != hipSuccess) { fprintf(stderr, "kernel_launch: memset failed\n"); return; }
    Args a{};
    for (int i = 0; i < 26; ++i) a.in[i] = (const float*)d_in[i];
    a.out = (float*)d_out; a.ws = (unsigned char*)d_ws;
#if MK_PER_PHASE
    for (int p = 0; p < NPHASE; ++p) { a.ph_lo = p; a.ph_hi = p + 1; hipLaunchKernelGGL(fwd_kernel, dim3(grid), dim3(NTHR), LDS_BYTES, stream, a); }
#else
    a.ph_lo = 0; a.ph_hi = NPHASE;
    void* kargs[] = {&a};
    hipError_t e = hipLaunchCooperativeKernel((const void*)fwd_kernel, dim3(grid), dim3(NTHR), kargs, LDS_BYTES, stream);
    if (e != hipSuccess) fprintf(stderr, "kernel_launch: cooperative launch failed: %s\n", hipGetErrorString(e));
#endif
}
```
